# Optimizing an MI355X kernel written in HIP

```python
import math
import jax, jax.numpy as jnp
from jax import lax
import numpy as np

D_MODEL = 1024
BATCH = 8
SEQ = 2048
DEPTH = 4

N_MIXERS = 2
N_HEADS = 16
HEAD_DIM = D_MODEL // N_HEADS
CONV_WIDTH = 3
BRANCHES = ((128, 1), (512, 4), (2048, 16))
NUM_BUCKETS = 32
MAX_DISTANCE = 2048
D_FF = ((8 * D_MODEL // 3 + 255) // 256) * 256
EPS = 1e-6
NEG_INF = -1e30

kernel_name = "hybrid_shortconv_dilated_attn_swiglu"


def rms_norm(x, g):
    xf = x.astype(jnp.float32)
    y = xf * lax.rsqrt(jnp.mean(xf * xf, axis=-1, keepdims=True) + EPS)
    return (y * g.astype(jnp.float32)).astype(x.dtype)


def t5_bucket(dist):
    exact = NUM_BUCKETS // 2
    df = jnp.maximum(dist, 1).astype(jnp.float32)
    large = exact + (jnp.log(df / exact) / math.log(MAX_DISTANCE / exact)
                     * (NUM_BUCKETS - exact)).astype(jnp.int32)
    large = jnp.minimum(large, NUM_BUCKETS - 1)
    return jnp.where(dist < exact, dist, large)


def short_conv_mixer(h, w_in, conv_k, w_out):
    b, c, u = jnp.split(h @ w_in, 3, axis=-1)
    y = lax.conv_general_dilated(
        c * u, conv_k[:, None, :].astype(u.dtype),
        window_strides=(1,), padding=[(CONV_WIDTH - 1, 0)],
        dimension_numbers=("NWC", "WIO", "NWC"),
        feature_group_count=D_MODEL)
    return (b * y) @ w_out


def dilated_branch(q, k, v, rel_bias, window, dilation):
    bsz, seq, nh, dh = q.shape
    blk = window // dilation
    L = seq // dilation
    nb = -(-L // blk)
    Lp = nb * blk

    def sub(t):
        t = t.reshape(bsz, L, dilation, nh, dh).transpose(0, 2, 1, 3, 4)
        t = jnp.pad(t, ((0, 0), (0, 0), (0, Lp - L), (0, 0), (0, 0)))
        return t.reshape(bsz, dilation, nb, blk, nh, dh)

    def with_prev(t):
        prev = jnp.pad(t, ((0, 0), (0, 0), (1, 0), (0, 0), (0, 0), (0, 0)))[:, :, :-1]
        return jnp.concatenate([prev, t], axis=3)

    qb = sub(q)
    kk = with_prev(sub(k))
    vv = with_prev(sub(v))

    s = jnp.einsum("brnqhd,brnkhd->brnhqk", qb, kk,
                   preferred_element_type=jnp.float32) * (HEAD_DIM ** -0.5)
    qi = jnp.arange(blk)[:, None]
    ki = jnp.arange(2 * blk)[None, :]
    rel = qi + blk - ki
    band = (rel >= 0) & (rel <= blk)
    valid_start = (jnp.arange(nb)[:, None, None] > 0) | (ki >= blk)[None]
    mask = band[None] & valid_start
    bias = rel_bias[t5_bucket(jnp.clip(rel, 0) * dilation)]
    s = s + bias.transpose(2, 0, 1).astype(jnp.float32)
    s = jnp.where(mask[:, None], s, NEG_INF)
    lse = jax.nn.logsumexp(s, axis=-1)
    p = jnp.exp(s - lse[..., None])
    o = jnp.einsum("brnhqk,brnkhd->brnqhd", p.astype(v.dtype), vv,
                   preferred_element_type=jnp.float32)

    o = o.reshape(bsz, dilation, Lp, nh, dh)[:, :, :L]
    o = o.transpose(0, 2, 1, 3, 4).reshape(bsz, seq, nh, dh)
    lse = lse.transpose(0, 1, 2, 4, 3).reshape(bsz, dilation, Lp, nh)[:, :, :L]
    lse = lse.transpose(0, 2, 1, 3).reshape(bsz, seq, nh)
    return o, lse


def dilated_attention_mixer(h, w_qkv, w_out, rel_bias):
    bsz, seq, _ = h.shape
    qkv = (h @ w_qkv).reshape(bsz, seq, 3, N_HEADS, HEAD_DIM)
    q, k, v = qkv[:, :, 0], qkv[:, :, 1], qkv[:, :, 2]
    outs, lses = [], []
    for window, dilation in BRANCHES:
        o, l = dilated_branch(q, k, v, rel_bias, window, dilation)
        outs.append(o)
        lses.append(l)
    alpha = jax.nn.softmax(jnp.stack(lses, axis=0), axis=0)
    o = jnp.sum(alpha[..., None] * jnp.stack(outs, axis=0), axis=0)
    return o.reshape(bsz, seq, D_MODEL).astype(h.dtype) @ w_out


def swiglu(h, w_gate, w_up, w_down):
    return (jax.nn.silu(h @ w_gate) * (h @ w_up)) @ w_down


def setup_inputs(seed: int = 0) -> dict:
    key = jax.random.key(seed)
    ks = jax.random.split(key, 14)
    n_conv = (DEPTH + 1) // 2
    n_attn = DEPTH // 2
    f32 = jnp.float32
    nrm = lambda k, shape, scale: jax.random.normal(k, shape, f32) * scale
    return {
        "x": nrm(ks[0], (BATCH, SEQ, D_MODEL), 1.0),
        "mix_norm": 1.0 + nrm(ks[1], (DEPTH, D_MODEL), 0.05),
        "ffn_norm": 1.0 + nrm(ks[2], (DEPTH, D_MODEL), 0.05),
        "final_norm": 1.0 + nrm(ks[3], (D_MODEL,), 0.05),
        "conv_w_in": nrm(ks[4], (n_conv, D_MODEL, 3 * D_MODEL), D_MODEL ** -0.5),
        "conv_kernel": nrm(ks[5], (n_conv, CONV_WIDTH, D_MODEL), CONV_WIDTH ** -0.5),
        "conv_w_out": nrm(ks[6], (n_conv, D_MODEL, D_MODEL), D_MODEL ** -0.5),
        "attn_w_qkv": nrm(ks[7], (n_attn, D_MODEL, 3 * D_MODEL), D_MODEL ** -0.5),
        "attn_w_out": nrm(ks[8], (n_attn, D_MODEL, D_MODEL), D_MODEL ** -0.5),
        "rel_bias": nrm(ks[9], (NUM_BUCKETS, N_HEADS), 0.2),
        "ffn_w_gate": nrm(ks[10], (DEPTH, D_MODEL, D_FF), D_MODEL ** -0.5),
        "ffn_w_up": nrm(ks[11], (DEPTH, D_MODEL, D_FF), D_MODEL ** -0.5),
        "ffn_w_down": nrm(ks[12], (DEPTH, D_FF, D_MODEL), D_FF ** -0.5),
    }


def reference(x, mix_norm, ffn_norm, final_norm, conv_w_in, conv_kernel, conv_w_out,
              attn_w_qkv, attn_w_out, rel_bias, ffn_w_gate, ffn_w_up, ffn_w_down):
    for i in range(DEPTH):
        h = rms_norm(x, mix_norm[i])
        j = i // N_MIXERS
        if i % N_MIXERS == 0:
            x = x + short_conv_mixer(h, conv_w_in[j], conv_kernel[j], conv_w_out[j])
        else:
            x = x + dilated_attention_mixer(h, attn_w_qkv[j], attn_w_out[j], rel_bias)
        h = rms_norm(x, ffn_norm[i])
        x = x + swiglu(h, ffn_w_gate[i], ffn_w_up[i], ffn_w_down[i])
    return rms_norm(x, final_norm)
```

```cpp
#include <hip/hip_runtime.h>
#include <cstdio>
#include <cstdint>
namespace pg8 {
#define PG8_LAS __attribute__((address_space(3)))
typedef unsigned short bf16_t;
typedef short bf16x8 __attribute__((ext_vector_type(8)));
typedef float f32x4 __attribute__((ext_vector_type(4)));
typedef unsigned u32x4 __attribute__((ext_vector_type(4)));
constexpr int BM = 256, BK = 64, HALF = 128, HTB = HALF * BK * 2  , STAGE_BYTES = 8 * HTB, NXCD = 8, WGM = 4;

__host__ __device__ __forceinline__ int lds_byte(int r, int c) { const int st = (r >> 4) * 2 + (c >> 5), rr = r & 15, cc = c & 31, ob = rr * 64 + cc * 2; return st * 1024 + (ob ^ (((ob >> 9) & 1) << 5)); }
__host__ __device__ __forceinline__ void stage_rc(int b, int& R, int& C) { const int st = b / 1024, sb = b % 1024, swz = sb ^ (((sb >> 9) & 1) << 5); R = (st >> 1) * 16 + swz / 64; C = (st & 1) * 32 + (swz % 64) / 2; }
__host__ __device__ __forceinline__ int perm32(int rho) { const int n = rho >> 4, i = rho & 15; return 8 * (i >> 2) + 4 * n + (i & 3); }

struct Unit { int pm, pn, ord; };
struct Gemm { const bf16_t* A; const bf16_t* Bt; int M, N, K; };

struct StaticOrder {
    int nM, nN, nwg, G, c;
    __host__ __device__ void init(int M, int N, int G_, int c_) { nM = M / BM; nN = N / BM; nwg = nM * nN; G = G_; c = c_; }
    __host__ __device__ bool next(int i, Unit& u) const {
        const long L = (long)i * G + c; if (L >= nwg) return false;
        int wgid = (int)L; { const int q = nwg / NXCD, r = nwg % NXCD, xcd = wgid % NXCD, off = wgid / NXCD; wgid = (xcd < r ? xcd * (q + 1) : r * (q + 1) + (xcd - r) * q) + off; }
        const int nig = WGM * nN, gid = wgid / nig, fm = gid * WGM, gsz = (nM - fm) < WGM ? (nM - fm) : WGM;
        u.pm = fm + ((wgid % nig) % gsz); u.pn = (wgid % nig) / gsz; u.ord = i; return true;
    }
    __device__ __forceinline__ void a_ready(const Unit&) const {}
    __device__ __forceinline__ void done(const Unit&) const {}
    __device__ __forceinline__ void after_first_stage() const {}
};

constexpr int MROWS = 16384;
#ifndef USE_F16
#define USE_F16 0
#endif
typedef _Float16 h16x2 __attribute__((ext_vector_type(2))); typedef _Float16 h16x8 __attribute__((ext_vector_type(8))); typedef float f32x2c __attribute__((ext_vector_type(2)));
#if USE_F16
__device__ __forceinline__ unsigned cvt_pk_bf16(float lo, float hi) { const f32x2c v = {lo, hi}; return __builtin_bit_cast(unsigned, __builtin_convertvector(v, h16x2)); }
#define PG8_MFMA16(a, b, c) __builtin_amdgcn_mfma_f32_16x16x32_f16(__builtin_bit_cast(pg8::h16x8, (a)), __builtin_bit_cast(pg8::h16x8, (b)), (c), 0, 0, 0)
#else
typedef __bf16 bf16x2c __attribute__((ext_vector_type(2)));
__device__ __forceinline__ unsigned cvt_pk_bf16(float lo, float hi) { const f32x2c v = {lo, hi}; return __builtin_bit_cast(unsigned, __builtin_convertvector(v, bf16x2c)); }
#define PG8_MFMA16(a, b, c) __builtin_amdgcn_mfma_f32_16x16x32_bf16((a), (b), (c), 0, 0, 0)
#endif
__device__ __forceinline__ u32x4 pack8(const f32x4 v0, const f32x4 v1) { u32x4 w; w.x = cvt_pk_bf16(v0[0], v0[1]); w.y = cvt_pk_bf16(v0[2], v0[3]); w.z = cvt_pk_bf16(v1[0], v1[1]); w.w = cvt_pk_bf16(v1[2], v1[3]); return w; }
__device__ __forceinline__ float row_rstd(const float* ssq, int row) {
    const float s = (ssq[row] + ssq[MROWS + row]) + (ssq[2 * MROWS + row] + ssq[3 * MROWS + row]);
    return __builtin_amdgcn_rsqf(s * (1.0f / 1024.0f) + 1e-6f);
}
#define XPOSE_SETUP(stg_, wr_, wc_, fr_, fq_) const int xp_lane = (fq_) * 16 + (fr_), xp_tr = xp_lane >> 2, xp_tc = xp_lane & 3; PG8_LAS unsigned char* const xp_sl = (stg_) + ((wr_) * 4 + (wc_)) * 2048; \
    const int xp_wo = (fr_) * 64 + (((fq_) ^ ((fr_) >> 2)) << 4), xp_ro = xp_tr * 64 + ((xp_tc ^ (xp_tr >> 2)) << 4)
__device__ __forceinline__ u32x4 xpose_turn(PG8_LAS unsigned char* slot, int wo, int ro, const u32x4 v) { *(PG8_LAS u32x4*)(slot + wo) = v; return *(const PG8_LAS u32x4*)(slot + ro); }
#define XPOSE_TURN(slot_, v_) xpose_turn(xp_sl + (slot_) * 1024, xp_wo, xp_ro, (v_))
struct EpiQKV {
    static constexpr bool PERM = true, AFTER_DRAIN = false, LAST_DRAINED = false;
    bf16_t* O; const PG8_LAS float* rs; float c2; PG8_LAS unsigned char* stg;
    __device__ __forceinline__ void operator()(const f32x4 (&acc)[2][2][4][2], const Unit& u, int wr, int wc, int fr, int fq) const {
        XPOSE_SETUP(stg, wr, wc, fr, fq);
        const int row0 = u.pm * BM + wr * 64 + xp_tr, col0 = u.pn * BM + wc * 32 + 8 * xp_tc;
        const float sc = (u.pn < 4) ? c2 : 1.0f;
#pragma unroll
        for (int ai = 0; ai < 2; ++ai)
#pragma unroll
            for (int m = 0; m < 4; ++m) { const int row = row0 + ai * HALF + m * 16; const float rs = this->rs[u.ord * BM + ai * HALF + wr * 64 + m * 16 + fr] * sc; bf16_t* rowp = O + (size_t)row * 3072 + col0;
#pragma unroll
                for (int bj = 0; bj < 2; ++bj) *(u32x4*)(rowp + bj * HALF) = XPOSE_TURN(bj, pack8(acc[ai][bj][m][0] * rs, acc[ai][bj][m][1] * rs)); }
    }
};
struct EpiConvIn {
    static constexpr bool PERM = true, AFTER_DRAIN = false, LAST_DRAINED = false;
    bf16_t* Bo; bf16_t* CU; const PG8_LAS float* rs; PG8_LAS unsigned char* stg;
    __device__ __forceinline__ void operator()(const f32x4 (&acc)[2][2][4][2], const Unit& u, int wr, int wc, int fr, int fq) const {
        XPOSE_SETUP(stg, wr, wc, fr, fq);
        const int row0 = u.pm * BM + wr * 64 + xp_tr;
        if (u.pn < 4) {
            const int col0 = u.pn * BM + wc * 32 + 8 * xp_tc;
#pragma unroll
            for (int ai = 0; ai < 2; ++ai)
#pragma unroll
                for (int m = 0; m < 4; ++m) { const int row = row0 + ai * HALF + m * 16; const float rs = this->rs[u.ord * BM + ai * HALF + wr * 64 + m * 16 + fr]; bf16_t* rowp = Bo + (size_t)row * 1024 + col0;
#pragma unroll
                    for (int bj = 0; bj < 2; ++bj) *(u32x4*)(rowp + bj * HALF) = XPOSE_TURN(bj, pack8(acc[ai][bj][m][0] * rs, acc[ai][bj][m][1] * rs)); }
        } else {
            const int col0 = (u.pn - 4) * HALF + wc * 32 + 8 * xp_tc;
#pragma unroll
            for (int ai = 0; ai < 2; ++ai)
#pragma unroll
                for (int m = 0; m < 4; ++m) { const int row = row0 + ai * HALF + m * 16; const float rs = this->rs[u.ord * BM + ai * HALF + wr * 64 + m * 16 + fr]; const float rs2 = rs * rs;
                    *(u32x4*)(CU + (size_t)row * 1024 + col0) = XPOSE_TURN(m & 1, pack8(acc[ai][0][m][0] * acc[ai][1][m][0] * rs2, acc[ai][0][m][1] * acc[ai][1][m][1] * rs2)); }
        }
    }
};
__device__ __forceinline__ f32x4 swiglu4(const f32x4 g, const f32x4 u, float rs) {
    const f32x4 gk = g * (rs * -1.4426950408889634f);
    f32x4 t; t[0] = __builtin_amdgcn_exp2f(gk[0]); t[1] = __builtin_amdgcn_exp2f(gk[1]); t[2] = __builtin_amdgcn_exp2f(gk[2]); t[3] = __builtin_amdgcn_exp2f(gk[3]);
    const f32x4 d = t + 1.0f;
    f32x4 r; r[0] = __builtin_amdgcn_rcpf(d[0]); r[1] = __builtin_amdgcn_rcpf(d[1]); r[2] = __builtin_amdgcn_rcpf(d[2]); r[3] = __builtin_amdgcn_rcpf(d[3]);
    return (g * u) * (r * (rs * rs));
}
struct EpiSwiGLU {
    static constexpr bool PERM = true, AFTER_DRAIN = false, LAST_DRAINED = false;
    bf16_t* Hd; const PG8_LAS float* rs; PG8_LAS unsigned char* stg;
    __device__ __forceinline__ void operator()(const f32x4 (&acc)[2][2][4][2], const Unit& u, int wr, int wc, int fr, int fq) const {
        XPOSE_SETUP(stg, wr, wc, fr, fq);
        const int row0 = u.pm * BM + wr * 64 + xp_tr, col0 = u.pn * HALF + wc * 32 + 8 * xp_tc;
#pragma unroll
        for (int ai = 0; ai < 2; ++ai)
#pragma unroll
            for (int m = 0; m < 4; ++m) { const int row = row0 + ai * HALF + m * 16; const float rs = this->rs[u.ord * BM + ai * HALF + wr * 64 + m * 16 + fr];
                *(u32x4*)(Hd + (size_t)row * 2816 + col0) = XPOSE_TURN(m & 1, pack8(swiglu4(acc[ai][0][m][0], acc[ai][1][m][0], rs), swiglu4(acc[ai][0][m][1], acc[ai][1][m][1], rs))); }
    }
};
__device__ __forceinline__ void unpack8f(const u32x4 w, f32x4& a, f32x4& b) {
#if USE_F16
    const unsigned w0 = w.x, w1 = w.y, w2 = w.z, w3 = w.w;
    const f32x2c p0 = __builtin_convertvector(__builtin_bit_cast(h16x2, w0), f32x2c), p1 = __builtin_convertvector(__builtin_bit_cast(h16x2, w1), f32x2c);
    const f32x2c p2 = __builtin_convertvector(__builtin_bit_cast(h16x2, w2), f32x2c), p3 = __builtin_convertvector(__builtin_bit_cast(h16x2, w3), f32x2c);
    a[0] = p0.x; a[1] = p0.y; a[2] = p1.x; a[3] = p1.y; b[0] = p2.x; b[1] = p2.y; b[2] = p3.x; b[3] = p3.y;
#else
    a[0] = __builtin_bit_cast(float, w.x << 16); a[1] = __builtin_bit_cast(float, w.x & 0xffff0000u); a[2] = __builtin_bit_cast(float, w.y << 16); a[3] = __builtin_bit_cast(float, w.y & 0xffff0000u);
    b[0] = __builtin_bit_cast(float, w.z << 16); b[1] = __builtin_bit_cast(float, w.z & 0xffff0000u); b[2] = __builtin_bit_cast(float, w.w << 16); b[3] = __builtin_bit_cast(float, w.w & 0xffff0000u);
#endif
}
struct EpiRes {
    static constexpr bool PERM = true, AFTER_DRAIN = true, LAST_DRAINED = false;
    bf16_t* xb; float* ssq;
    __device__ __forceinline__ void fused(f32x4 (&acc)[2][2][4][2], const Unit& u, int wr, int wc, int fr, int fq, PG8_LAS unsigned char* lds, int wid, int lane) const {
        PG8_LAS float* P = (PG8_LAS float*)lds;
        const int col0 = u.pn * BM + wc * 32 + 8 * fq;
        u32x4 xr[2][4][2];
#pragma unroll
        for (int ai = 0; ai < 2; ++ai)
#pragma unroll
            for (int m = 0; m < 4; ++m) { const size_t off = (size_t)(u.pm * BM + ai * HALF + wr * 64 + m * 16 + fr) * 1024 + col0;
#pragma unroll
                for (int bj = 0; bj < 2; ++bj) xr[ai][m][bj] = *(const u32x4*)(xb + off + bj * HALF); }
#pragma unroll
        for (int ai = 0; ai < 2; ++ai)
#pragma unroll
            for (int m = 0; m < 4; ++m) { const int rl = ai * HALF + wr * 64 + m * 16 + fr; const size_t off = (size_t)(u.pm * BM + rl) * 1024 + col0; float s = 0.f;
#pragma unroll
                for (int bj = 0; bj < 2; ++bj) { f32x4 x0, x1; unpack8f(xr[ai][m][bj], x0, x1);
                    const f32x4 v0 = acc[ai][bj][m][0] + x0, v1 = acc[ai][bj][m][1] + x1;
                    *(u32x4*)(xb + off + bj * HALF) = pack8(v0, v1);
                    s += (v0[0] * v0[0] + v0[1] * v0[1]) + (v0[2] * v0[2] + v0[3] * v0[3]) + (v1[0] * v1[0] + v1[1] * v1[1]) + (v1[2] * v1[2] + v1[3] * v1[3]); }
                s += __shfl_xor(s, 16); s += __shfl_xor(s, 32);
                if (fq == 0) P[rl * 4 + wc] = s; }
        asm volatile("s_waitcnt lgkmcnt(0)" ::: "memory"); __builtin_amdgcn_s_barrier(); asm volatile("" ::: "memory");
        const int t = wid * 64 + lane;
        if (t < 256) { const f32x4 p = *(const PG8_LAS f32x4*)(P + t * 4); ssq[(size_t)u.pn * MROWS + u.pm * BM + t] = (p[0] + p[1]) + (p[2] + p[3]); }
    }
};

template <class Epi, class Sched, bool ALIGN_EPI = false, bool SP2 = false>
__device__ __forceinline__ void gemm_phase(PG8_LAS unsigned char* lds, const Gemm g, const Sched& S, const Epi& E) {
    const int tid = threadIdx.x, wid = __builtin_amdgcn_readfirstlane(tid >> 6), lane = tid & 63, wr = wid >> 2, wc = wid & 3, fr = lane & 15, fq = lane >> 4;
    const int K = g.K, nt = K / BK;
    unsigned voffA[2], voffB[2];
#pragma unroll
    for (int i = 0; i < 2; ++i) { int R, C; stage_rc(tid * 16 + i * 8192, R, C); const int Rb = Epi::PERM ? ((R & ~31) + perm32(R & 31)) : R;
        voffA[i] = (unsigned)(R * K + C) * 2u; voffB[i] = (unsigned)(Rb * K + C) * 2u; }
    const size_t kstep = (size_t)(BK * 2);
    const size_t hstep = (size_t)HALF * K * 2;
    const size_t tstep = 2 * hstep;
    const unsigned ldsw = (unsigned)wid * 1024u;
    const int aoff = lds_byte(wr * 64 + fr, fq * 8), boff = lds_byte(wc * 32 + fr, fq * 8);
#define PG8_SA(b, h) (((b) * 2 + (h)) * HTB)
#define PG8_SB(b, h) ((4 + (b) * 2 + (h)) * HTB)
#define PG8_STAGE(bufoff, gbase, voff) do { _Pragma("unroll") for (int _i = 0; _i < 2; ++_i) \
        __builtin_amdgcn_global_load_lds((const unsigned*)((const char*)(gbase) + (voff)[_i]), (PG8_LAS unsigned*)(lds + (bufoff) + ldsw + _i * 8192), 16, 0, 0); } while (0)
#define PG8_LDA(dst, b, h) do { _Pragma("unroll") for (int m = 0; m < 4; ++m) _Pragma("unroll") for (int k = 0; k < 2; ++k) dst[m][k] = *(const PG8_LAS bf16x8*)(lds + PG8_SA(b, h) + aoff + m * 2048 + k * 1024); } while (0)
#define PG8_LDB(dst, b, h) do { _Pragma("unroll") for (int n = 0; n < 2; ++n) _Pragma("unroll") for (int k = 0; k < 2; ++k) dst[n][k] = *(const PG8_LAS bf16x8*)(lds + PG8_SB(b, h) + boff + n * 2048 + k * 1024); } while (0)
#define PG8_MMA(ai, bj, At, Bt) do { __builtin_amdgcn_s_setprio(1); _Pragma("unroll") for (int m = 0; m < 4; ++m) _Pragma("unroll") for (int n = 0; n < 2; ++n) _Pragma("unroll") for (int k = 0; k < 2; ++k) \
        acc[ai][bj][m][n] = PG8_MFMA16(Bt[n][k], At[m][k], acc[ai][bj][m][n]); __builtin_amdgcn_s_setprio(0); } while (0)
#define PG8_WAIT_V(n) asm volatile("s_waitcnt vmcnt(" #n ")" ::: "memory")
#define PG8_WAIT_L(n) asm volatile("s_waitcnt lgkmcnt(" #n ")" ::: "memory")
#define PG8_BAR __builtin_amdgcn_s_barrier()
#define PG8_SCHED __builtin_amdgcn_sched_barrier(0)
    Unit cur, nxt; int ui = 0;
    if (!S.next(0, cur)) return;
    f32x4 acc[2][2][4][2];
#pragma unroll
    for (int a = 0; a < 2; ++a)
#pragma unroll
        for (int b = 0; b < 2; ++b)
#pragma unroll
            for (int m = 0; m < 4; ++m)
#pragma unroll
                for (int n = 0; n < 2; ++n) acc[a][b][m][n] = (f32x4){0.f, 0.f, 0.f, 0.f};
    bf16x8 At[4][2], B0[2][2], B1[2][2];
    const char* cA = (const char*)g.A + (size_t)cur.pm * tstep; const char* cB = (const char*)g.Bt + (size_t)cur.pn * tstep;
    S.a_ready(cur);
    if constexpr (SP2) {
        PG8_STAGE(PG8_SB(0, 0), cB, voffB); PG8_STAGE(PG8_SB(0, 1), cB + hstep, voffB); PG8_STAGE(PG8_SA(0, 0), cA, voffA); PG8_STAGE(PG8_SA(0, 1), cA + hstep, voffA);
        S.after_first_stage();
        if (wr == 1) PG8_BAR;
        PG8_WAIT_V(2); PG8_BAR;
        PG8_STAGE(PG8_SB(1, 0), cB + kstep, voffB); PG8_STAGE(PG8_SA(1, 0), cA + kstep, voffA); PG8_STAGE(PG8_SB(1, 1), cB + hstep + kstep, voffB);
        PG8_WAIT_V(6); PG8_BAR;
    } else {
        PG8_STAGE(PG8_SB(0, 0), cB, voffB); PG8_STAGE(PG8_SA(0, 0), cA, voffA); PG8_STAGE(PG8_SB(0, 1), cB + hstep, voffB); PG8_STAGE(PG8_SA(0, 1), cA + hstep, voffA);
        if (wr == 1) PG8_BAR;
        PG8_WAIT_V(4); PG8_BAR;
        PG8_STAGE(PG8_SB(1, 0), cB + kstep, voffB); PG8_STAGE(PG8_SA(1, 0), cA + kstep, voffA); PG8_STAGE(PG8_SB(1, 1), cB + hstep + kstep, voffB);
        PG8_WAIT_V(6); PG8_BAR;
    }
    for (;;) {
        const bool has_next = S.next(ui + 1, nxt);
        const char* nA = has_next ? (const char*)g.A + (size_t)nxt.pm * tstep : cA; const char* nB = has_next ? (const char*)g.Bt + (size_t)nxt.pn * tstep : cB;
        for (int t = 0; t < nt; t += 2) {
            const bool last = (t == nt - 2);
            const char* a1 = cA + (size_t)(t + 1) * kstep;
            const char* a2 = last ? nA : cA + (size_t)(t + 2) * kstep; const char* b2 = last ? nB : cB + (size_t)(t + 2) * kstep;
            const char* a3 = a2 + kstep; const char* b3 = b2 + kstep;
            if (last && has_next) S.a_ready(nxt);
            if constexpr (SP2) {
            PG8_LDB(B0, 0, 0); PG8_LDB(B1, 0, 1); PG8_SCHED; PG8_LDA(At, 0, 0); PG8_STAGE(PG8_SA(1, 1), a1 + hstep, voffA);
            PG8_WAIT_V(8); PG8_WAIT_L(0); PG8_BAR; PG8_MMA(0, 0, At, B0); PG8_MMA(0, 1, At, B1); PG8_BAR; PG8_SCHED;
            PG8_LDA(At, 0, 1); PG8_STAGE(PG8_SB(0, 0), b2, voffB); PG8_STAGE(PG8_SB(0, 1), b2 + hstep, voffB); PG8_STAGE(PG8_SA(0, 0), a2, voffA);
            PG8_WAIT_V(8); PG8_WAIT_L(0); PG8_BAR; PG8_MMA(1, 0, At, B0); PG8_MMA(1, 1, At, B1); PG8_BAR; PG8_SCHED;
            PG8_LDB(B0, 1, 0); PG8_LDB(B1, 1, 1); PG8_SCHED; PG8_LDA(At, 1, 0); PG8_STAGE(PG8_SA(0, 1), a2 + hstep, voffA);
            PG8_WAIT_V(8); PG8_WAIT_L(0); PG8_BAR; PG8_MMA(0, 0, At, B0); PG8_MMA(0, 1, At, B1); PG8_BAR; PG8_SCHED;
            PG8_LDA(At, 1, 1); PG8_STAGE(PG8_SB(1, 0), b3, voffB); PG8_STAGE(PG8_SB(1, 1), b3 + hstep, voffB); PG8_STAGE(PG8_SA(1, 0), a3, voffA);
            PG8_WAIT_V(8); PG8_WAIT_L(0); PG8_BAR; PG8_MMA(1, 0, At, B0); PG8_MMA(1, 1, At, B1); PG8_BAR; PG8_SCHED;
            } else {
            PG8_LDB(B0, 0, 0); PG8_SCHED; PG8_LDA(At, 0, 0); PG8_STAGE(PG8_SA(1, 1), a1 + hstep, voffA);
            PG8_WAIT_L(8); PG8_BAR; PG8_WAIT_L(0); PG8_MMA(0, 0, At, B0); PG8_BAR; PG8_SCHED;
            PG8_LDB(B1, 0, 1); PG8_STAGE(PG8_SB(0, 0), b2, voffB);
            PG8_BAR; PG8_WAIT_L(0); PG8_MMA(0, 1, At, B1); PG8_BAR;
            PG8_LDA(At, 0, 1); PG8_STAGE(PG8_SA(0, 0), a2, voffA);
            PG8_BAR; PG8_WAIT_L(0); PG8_MMA(1, 0, At, B0); PG8_BAR; PG8_SCHED;
            PG8_STAGE(PG8_SB(0, 1), b2 + hstep, voffB);
            PG8_WAIT_V(6); PG8_BAR; PG8_MMA(1, 1, At, B1); PG8_BAR;
            PG8_LDB(B0, 1, 0); PG8_SCHED; PG8_LDA(At, 1, 0); PG8_STAGE(PG8_SA(0, 1), a2 + hstep, voffA);
            PG8_WAIT_L(8); PG8_BAR; PG8_WAIT_L(0); PG8_MMA(0, 0, At, B0); PG8_BAR; PG8_SCHED;
            PG8_LDB(B1, 1, 1); PG8_STAGE(PG8_SB(1, 0), b3, voffB);
            PG8_BAR; PG8_WAIT_L(0); PG8_MMA(0, 1, At, B1); PG8_BAR;
            PG8_LDA(At, 1, 1); PG8_STAGE(PG8_SA(1, 0), a3, voffA);
            PG8_BAR; PG8_WAIT_L(0); PG8_MMA(1, 0, At, B0); PG8_BAR; PG8_SCHED;
            PG8_STAGE(PG8_SB(1, 1), b3 + hstep, voffB);
            PG8_WAIT_V(6); PG8_BAR; PG8_MMA(1, 1, At, B1); PG8_BAR;
            }
        }
        if constexpr (ALIGN_EPI) { if (wr == 0) PG8_BAR; }
        if constexpr (!Epi::AFTER_DRAIN) { if (!Epi::LAST_DRAINED || has_next) E(acc, cur, wr, wc, fr, fq);
#if defined(DUP_EPI)
            asm volatile("" ::: "memory"); E(acc, cur, wr, wc, fr, fq);
#endif
            S.done(cur); }
        if (!has_next) break;
#pragma unroll
        for (int a = 0; a < 2; ++a)
#pragma unroll
            for (int b = 0; b < 2; ++b)
#pragma unroll
                for (int m = 0; m < 4; ++m)
#pragma unroll
                    for (int n = 0; n < 2; ++n) acc[a][b][m][n] = (f32x4){0.f, 0.f, 0.f, 0.f};
        cur = nxt; cA = nA; cB = nB; ++ui;
        if constexpr (ALIGN_EPI) { if (wr == 1) PG8_BAR; }
    }
    PG8_WAIT_V(0);
    if constexpr (!ALIGN_EPI) { if (wr == 0) PG8_BAR; }
    PG8_BAR;
    if constexpr (Epi::AFTER_DRAIN || Epi::LAST_DRAINED) { E.fused(acc, cur, wr, wc, fr, fq, lds, wid, lane); S.done(cur); }
#undef PG8_SA
#undef PG8_SB
#undef PG8_STAGE
#undef PG8_LDA
#undef PG8_LDB
#undef PG8_MMA
#undef PG8_WAIT_V
#undef PG8_WAIT_L
#undef PG8_BAR
#undef PG8_SCHED
}
}

constexpr int NWAVES = 8;
constexpr int BATCH = 8, SEQ = 2048, D = 1024, DEPTH = 4, NH = 16, HD = 64, FF = 2816, NB = 32;
constexpr int M = BATCH * SEQ;
constexpr float C2 = 0.125f * 1.4426950408889634f;
constexpr float LOG2E = 1.4426950408889634f;

constexpr size_t MiB = 1u << 20;
constexpr size_t WS_CTL = 0, CTL_ZERO_BYTES = 64 * 1024;
constexpr size_t WS_SSQ = 1 * MiB;
constexpr size_t WS_W = 2 * MiB;
constexpr size_t W_IN_OFF = 0, W_OUT_OFF = (size_t)3072 * 1024 * 2, W_GU_OFF = W_OUT_OFF + (size_t)1024 * 1024 * 2, W_DN_OFF = W_GU_OFF + (size_t)5632 * 1024 * 2;
constexpr size_t W_LAYER = W_DN_OFF + (size_t)1024 * 2816 * 2;
constexpr size_t WS_XB = 100 * MiB;
constexpr size_t WS_ACT = 132 * MiB;
constexpr size_t WS_MIX = 228 * MiB;
constexpr size_t WS_END = 260 * MiB;
static_assert(WS_W + 4 * W_LAYER <= WS_XB && WS_MIX + (size_t)M * D * 2 <= WS_END, "d_ws map");
constexpr int CW_TMO = 0;
constexpr int CW_BAR = 1024;

constexpr int RING_OFF = 0, RING_BYTES = 131072;
constexpr int LDS_BYTES = 163840;
constexpr int LDSCTL_OFF = LDS_BYTES - 1024, MISC_OFF = LDSCTL_OFF + 320;

#define GAS __attribute__((address_space(1)))
#define LAS __attribute__((address_space(3)))
typedef unsigned short bf16;
typedef unsigned v4u __attribute__((ext_vector_type(4)));
typedef float f32x4 __attribute__((ext_vector_type(4)));
typedef GAS unsigned gu32;
#define RLX_AGENT __ATOMIC_RELAXED, __HIP_MEMORY_SCOPE_AGENT
#define LDS_WAIT() asm volatile("s_waitcnt lgkmcnt(0)" ::: "memory")
#define VM_WAIT() asm volatile("s_waitcnt vmcnt(0)" ::: "memory")
#if USE_F16
__device__ __forceinline__ unsigned f2bf(float f) { return (unsigned)__builtin_bit_cast(unsigned short, (_Float16)f); }
__device__ __forceinline__ unsigned pk2(float lo, float hi) { return pg8::cvt_pk_bf16(lo, hi); }
__device__ __forceinline__ float bf2f(unsigned short b) { return (float)__builtin_bit_cast(_Float16, b); }
#else
__device__ __forceinline__ unsigned f2bf(float f) { unsigned u = __builtin_bit_cast(unsigned, f); return (u + 0x7fffu + ((u >> 16) & 1u)) >> 16; }
__device__ __forceinline__ unsigned pk2(float lo, float hi) { return pg8::cvt_pk_bf16(lo, hi); }
__device__ __forceinline__ float bf2f(unsigned short b) { return __builtin_bit_cast(float, (unsigned)b << 16); }
#endif

#define XB_TMO      128
#define XB_XCNT(j)  (256  + 64 * (j))
#define XB_XSUB(j)  (1280 + 64 * (j))
#define XB_XGEN(j)  (2304 + 64 * (j))
#define XB_TOP      3328
#define XB_TOPGEN   3392
#define XCD_BAR_WORDS 3456
#define XB_SPIN_CAP (1u << 18)
__device__ __forceinline__ unsigned xb_ld(unsigned* p)              { return __hip_atomic_load(p, __ATOMIC_RELAXED, __HIP_MEMORY_SCOPE_AGENT); }
__device__ __forceinline__ unsigned xb_add(unsigned* p, unsigned v) { return __hip_atomic_fetch_add(p, v, __ATOMIC_RELAXED, __HIP_MEMORY_SCOPE_AGENT); }
__device__ __forceinline__ unsigned xb_xcc_id() { return (unsigned)__builtin_amdgcn_s_getreg((3 << 11) | 20) & 0xFu; }
#define XB_SPIN(cond, bar) do { unsigned _sp = 0; while (cond) { __builtin_amdgcn_s_sleep(1); \
    if ((++_sp & 255u) == 0u) { if (xb_ld(&(bar)[XB_TMO])) break; if (_sp > XB_SPIN_CAP) { atomicAdd(&(bar)[XB_TMO], 1u); break; } } } } while (0)
struct XcdBarrier { unsigned* bar; unsigned x; volatile LAS unsigned* st; };
#define XB_LOC(j)   (3520 + 64 * (j))
__device__ __forceinline__ XcdBarrier xcd_barrier_post(unsigned* bar, volatile LAS unsigned* st) {
    XcdBarrier b; b.bar = bar; b.x = xb_xcc_id(); b.st = st;
    if (threadIdx.x == 0) st[2] = xb_add(&bar[XB_XCNT(b.x)], 1u);
    return b;
}
__device__ __forceinline__ void xcc_local_barrier(const XcdBarrier& b, unsigned& seq) {
    asm volatile("s_waitcnt vmcnt(0)" ::: "memory");
    __syncthreads();
    if (threadIdx.x == 0) {
        unsigned* bar = b.bar;
        __builtin_amdgcn_s_waitcnt(0);
        __builtin_amdgcn_fence(__ATOMIC_ACQUIRE, "agent");
        xb_add(&bar[XB_LOC(b.x)], 1u);
        const unsigned target = 32u * (seq + 1u);
        XB_SPIN(xb_ld(&bar[XB_LOC(b.x)]) < target, bar);
        asm volatile("s_waitcnt vmcnt(0)" ::: "memory");
    }
    __syncthreads();
    ++seq;
}
__device__ __forceinline__ void xcd_barrier_complete(unsigned* bar, unsigned x, unsigned& nloc, unsigned& nx) {
    const unsigned G = gridDim.x * gridDim.y * gridDim.z;
    unsigned sum, cnt, mine, sp = 0u;
    for (;;) {
        sum = 0u; cnt = 0u; mine = 0u;
#pragma unroll
        for (unsigned j = 0; j < 16; ++j) { const unsigned c = xb_ld(&bar[XB_XCNT(j)]); sum += c; cnt += (c > 0u) ? 1u : 0u; mine = (j == x) ? c : mine; }
        if (sum == G) break;
        __builtin_amdgcn_s_sleep(1);
        if ((++sp & 255u) == 0u) { if (xb_ld(&bar[XB_TMO])) break; if (sp > XB_SPIN_CAP) { atomicAdd(&bar[XB_TMO], 1u); break; } }
    }
    nloc = mine > 0u ? mine : 1u; nx = cnt > 0u ? cnt : 1u;
}
__device__ __forceinline__ void xcd_barrier(const XcdBarrier& b) {
    asm volatile("s_waitcnt vmcnt(0)" ::: "memory");
    __syncthreads();
    if (threadIdx.x == 0) {
        unsigned* bar = b.bar;
        __builtin_amdgcn_s_waitcnt(0);
        unsigned nloc = b.st[0], nx = b.st[1];
        if (nloc == 0u) { xcd_barrier_complete(bar, b.x, nloc, nx); b.st[0] = nloc; b.st[1] = nx; }
        const unsigned old = xb_add(&bar[XB_XSUB(b.x)], 1u);
        const unsigned gen = old / nloc;
        if (old + 1u == (gen + 1u) * nloc) {
            __builtin_amdgcn_fence(__ATOMIC_RELEASE, "agent");
            asm volatile("s_waitcnt vmcnt(0)" ::: "memory");
            const unsigned og = xb_add(&bar[XB_TOP], 1u);
            const unsigned tg = og / nx;
            if (og + 1u == (tg + 1u) * nx) xb_add(&bar[XB_TOPGEN], 1u);
            else XB_SPIN(xb_ld(&bar[XB_TOPGEN]) == tg, bar);
            __builtin_amdgcn_fence(__ATOMIC_ACQUIRE, "agent");
            xb_add(&bar[XB_XGEN(b.x)], 1u);
            asm volatile("s_waitcnt vmcnt(0)" ::: "memory");
        } else {
            XB_SPIN(xb_ld(&bar[XB_XGEN(b.x)]) == gen, bar);
            __builtin_amdgcn_fence(__ATOMIC_ACQUIRE, "agent");
            asm volatile("s_waitcnt vmcnt(0)" ::: "memory");
        }
    }
    __syncthreads();
}

struct Frame {
    LAS unsigned char* lds;
    volatile LAS unsigned* MISC;
    gu32* ctl;
    int tid, lane, wave, vcu, G;
};
__device__ __forceinline__ float wave_sum(float v) {
#pragma unroll
    for (int o = 1; o < 64; o <<= 1) v += __shfl_xor(v, o);
    return v;
}
__device__ __forceinline__ float wave_max(float v) {
#pragma unroll
    for (int o = 1; o < 64; o <<= 1) v = fmaxf(v, __shfl_xor(v, o));
    return v;
}

__device__ __forceinline__ void p0_transpose_item(const float* W, int K, int N, bf16* WT, int orow0, const float* gain, LAS unsigned char* T, int k0, int n0, int lane) {
    const int kq = lane >> 4, nl = (lane & 15) * 4;
    const GAS f32x4* src = (const GAS f32x4*)(W + (size_t)(k0 + 16 * kq) * N + n0 + nl);
    f32x4 v[16];
#pragma unroll
    for (int i = 0; i < 16; ++i) v[i] = __builtin_nontemporal_load(&src[(size_t)i * (N / 4)]);
    if (gain) {
        const GAS f32x4* gp = (const GAS f32x4*)(gain + k0 + 16 * kq);
#pragma unroll
        for (int q = 0; q < 4; ++q) { const f32x4 gq = gp[q];
#pragma unroll
            for (int e = 0; e < 4; ++e) v[4 * q + e] = v[4 * q + e] * gq[e]; }
    }
#pragma unroll
    for (int j = 0; j < 4; ++j) {
        const int n = nl + j, sw = (n >> 2) & 7;
        v4u a, b;
        a.x = pk2(v[0][j], v[1][j]); a.y = pk2(v[2][j], v[3][j]); a.z = pk2(v[4][j], v[5][j]); a.w = pk2(v[6][j], v[7][j]);
        b.x = pk2(v[8][j], v[9][j]); b.y = pk2(v[10][j], v[11][j]); b.z = pk2(v[12][j], v[13][j]); b.w = pk2(v[14][j], v[15][j]);
        *(LAS v4u*)(T + n * 128 + (((2 * kq) ^ sw) << 4)) = a;
        *(LAS v4u*)(T + n * 128 + (((2 * kq + 1) ^ sw) << 4)) = b;
    }
    LDS_WAIT(); asm volatile("" ::: "memory");
#pragma unroll
    for (int i = 0; i < 8; ++i) { const int n = 8 * i + (lane >> 3), c = lane & 7;
        const v4u o = *(const LAS v4u*)(T + n * 128 + ((c ^ ((n >> 2) & 7)) << 4));
        *(GAS v4u*)(WT + (size_t)(orow0 + n) * K + k0 + 8 * c) = o; }
    LDS_WAIT(); asm volatile("" ::: "memory");
}
struct Ptrs {
    const float *x, *mix_norm, *ffn_norm, *final_norm, *conv_w_in, *conv_kernel, *conv_w_out, *attn_w_qkv, *attn_w_out, *rel_bias, *w_gate, *w_up, *w_down;
    float* out; unsigned char* ws;
};
__device__ __forceinline__ void convert_layer_weights(Frame& F, const Ptrs& P, int li, int gw, int NGW, int part  ) {
    LAS unsigned char* scr = F.lds + RING_OFF + F.wave * 8192;
    constexpr int I_IN = 16 * 48, I_OUT = 16 * 16, I_G = 16 * 44, I_DN = 44 * 16, I_LAYER = I_IN + I_OUT + 2 * I_G + I_DN;
    const int j = li >> 1;
    bf16* wl = (bf16*)(P.ws + WS_W + (size_t)li * W_LAYER);
    const int it_lo = (part == 2) ? I_LAYER / 2 : 0, it_hi = (part == 1) ? I_LAYER / 2 : I_LAYER;
    for (int it = it_lo + gw; it < it_hi; it += NGW) {
        int r = it;
        if (r < I_IN) {
            const int kb = r / 48, nb = r % 48, n0 = nb * 64;
            if ((li & 1) == 0) {
                int orow; if (n0 < 1024) orow = n0; else if (n0 < 2048) { const int f = n0 - 1024; orow = 1024 + 256 * (f >> 7) + (f & 127); } else { const int f = n0 - 2048; orow = 1024 + 256 * (f >> 7) + 128 + (f & 127); }
                p0_transpose_item(P.conv_w_in + (size_t)j * 1024 * 3072, 1024, 3072, (bf16*)((char*)wl + W_IN_OFF), orow, P.mix_norm + li * 1024, scr, kb * 64, n0, F.lane);
            } else {
                p0_transpose_item(P.attn_w_qkv + (size_t)j * 1024 * 3072, 1024, 3072, (bf16*)((char*)wl + W_IN_OFF), n0, P.mix_norm + li * 1024, scr, kb * 64, n0, F.lane);
            }
            continue;
        }
        r -= I_IN;
        if (r < I_OUT) {
            const int kb = r / 16, nb = r % 16;
            const float* src = ((li & 1) == 0) ? P.conv_w_out + (size_t)j * 1024 * 1024 : P.attn_w_out + (size_t)j * 1024 * 1024;
            p0_transpose_item(src, 1024, 1024, (bf16*)((char*)wl + W_OUT_OFF), nb * 64, nullptr, scr, kb * 64, nb * 64, F.lane);
            continue;
        }
        r -= I_OUT;
        if (r < 2 * I_G) {
            const int up = r >= I_G; if (up) r -= I_G;
            const int kb = r / 44, nb = r % 44, n0 = nb * 64;
            const int orow = 256 * (n0 >> 7) + (up ? 128 : 0) + (n0 & 127);
            p0_transpose_item((up ? P.w_up : P.w_gate) + (size_t)li * 1024 * 2816, 1024, 2816, (bf16*)((char*)wl + W_GU_OFF), orow, P.ffn_norm + li * 1024, scr, kb * 64, n0, F.lane);
            continue;
        }
        r -= 2 * I_G;
        { const int kb = r / 16, nb = r % 16;
          p0_transpose_item(P.w_down + (size_t)li * 2816 * 1024, 2816, 1024, (bf16*)((char*)wl + W_DN_OFF), nb * 64, nullptr, scr, kb * 64, nb * 64, F.lane); }
    }
}
__device__ __forceinline__ void p0_prologue(Frame& F, const Ptrs& P) {
    const int gw = F.vcu * NWAVES + F.wave, NGW = F.G * NWAVES;
    bf16* xb = (bf16*)(P.ws + WS_XB); float* ssq = (float*)(P.ws + WS_SSQ);
    f32x4 xv[4][2][4];
#pragma unroll
    for (int tr = 0; tr < 4; ++tr) { const int m = 2 * gw + 2 * NGW * tr;
        if (m < M) {
#pragma unroll
            for (int rr = 0; rr < 2; ++rr) { const GAS f32x4* xr = (const GAS f32x4*)(P.x + (size_t)(m + rr) * D) + F.lane;
#pragma unroll
                for (int q = 0; q < 4; ++q) xv[tr][rr][q] = __builtin_nontemporal_load(&xr[64 * q]); } } }
    convert_layer_weights(F, P, 0, gw, NGW, 0);
#define P0_ROWS(v_, m_) do { float s[2] = {0.f, 0.f}; \
        _Pragma("unroll") for (int rr = 0; rr < 2; ++rr) { \
            _Pragma("unroll") for (int q = 0; q < 4; ++q) s[rr] += (v_[rr][q].x * v_[rr][q].x + v_[rr][q].y * v_[rr][q].y) + (v_[rr][q].z * v_[rr][q].z + v_[rr][q].w * v_[rr][q].w); \
            s[rr] = wave_sum(s[rr]); \
            GAS unsigned long long* o8 = (GAS unsigned long long*)(xb + (size_t)((m_) + rr) * D) + F.lane; \
            _Pragma("unroll") for (int q = 0; q < 4; ++q) o8[64 * q] = (unsigned long long)pk2(v_[rr][q].x, v_[rr][q].y) | ((unsigned long long)pk2(v_[rr][q].z, v_[rr][q].w) << 32); \
            if (F.lane < 4) ssq[(size_t)F.lane * M + (m_) + rr] = (F.lane == 0) ? s[rr] : 0.f; } } while (0)
#pragma unroll
    for (int tr = 0; tr < 4; ++tr) { const int m = 2 * gw + 2 * NGW * tr; if (m < M) P0_ROWS(xv[tr], m); }
    for (int m = 2 * gw + 8 * NGW; m < M; m += 2 * NGW) {
        f32x4 v[2][4];
#pragma unroll
        for (int rr = 0; rr < 2; ++rr) { const GAS f32x4* xr = (const GAS f32x4*)(P.x + (size_t)(m + rr) * D) + F.lane;
#pragma unroll
            for (int q = 0; q < 4; ++q) v[rr][q] = __builtin_nontemporal_load(&xr[64 * q]); }
        P0_ROWS(v, m);
    }
#undef P0_ROWS
}

__device__ __forceinline__ void unpack8(const v4u w, float (&f)[8]) {
    f32x4 a, b; pg8::unpack8f(w, a, b);
    f[0] = a[0]; f[1] = a[1]; f[2] = a[2]; f[3] = a[3]; f[4] = b[0]; f[5] = b[1]; f[6] = b[2]; f[7] = b[3];
}
__device__ __forceinline__ void conv_pass(Frame& F, const bf16* Bo, const bf16* CU, const float* ck, bf16* G) {
    const int nthr = F.G * NWAVES * 64;
    for (int item = F.vcu * (NWAVES * 64) + F.tid; item < (M / 16) * 128; item += nthr) {
        const int cg = item & 127, rb = item >> 7, t0 = rb * 16, c0 = cg * 8;
        float k0[8], k1[8], k2[8];
#pragma unroll
        for (int i = 0; i < 8; ++i) { k0[i] = ck[c0 + i]; k1[i] = ck[1024 + c0 + i]; k2[i] = ck[2048 + c0 + i]; }
        float p2[8], p1[8];
        if ((t0 & (SEQ - 1)) == 0) {
#pragma unroll
            for (int i = 0; i < 8; ++i) { p2[i] = 0.f; p1[i] = 0.f; }
        } else {
            unpack8(*(const GAS v4u*)(CU + (size_t)(t0 - 2) * 1024 + c0), p2); unpack8(*(const GAS v4u*)(CU + (size_t)(t0 - 1) * 1024 + c0), p1);
        }
        v4u cw[16], bw[16];
#pragma unroll
        for (int r = 0; r < 16; ++r) { cw[r] = *(const GAS v4u*)(CU + (size_t)(t0 + r) * 1024 + c0); bw[r] = *(const GAS v4u*)(Bo + (size_t)(t0 + r) * 1024 + c0); }
#pragma unroll
        for (int r = 0; r < 16; ++r) {
            float cur[8], bb[8]; unpack8(cw[r], cur); unpack8(bw[r], bb);
            float g[8];
#pragma unroll
            for (int i = 0; i < 8; ++i) { g[i] = bb[i] * (k0[i] * p2[i] + k1[i] * p1[i] + k2[i] * cur[i]); p2[i] = p1[i]; p1[i] = cur[i]; }
            v4u o; o.x = pk2(g[0], g[1]); o.y = pk2(g[2], g[3]); o.z = pk2(g[4], g[5]); o.w = pk2(g[6], g[7]);
            *(GAS v4u*)(G + (size_t)(t0 + r) * 1024 + c0) = o;
        }
    }
}

__device__ __forceinline__ int t5_bucket(int d) {
    if (d < 16) return d;
    int b = 16;
    b += (d >= 22); b += (d >= 30); b += (d >= 40); b += (d >= 54); b += (d >= 73); b += (d >= 99); b += (d >= 134); b += (d >= 182);
    b += (d >= 246); b += (d >= 332); b += (d >= 450); b += (d >= 609); b += (d >= 825); b += (d >= 1117); b += (d >= 1513);
    return b;
}
__device__ __forceinline__ void attn_simple(Frame& F, const bf16* QKV, const float* rel_bias, bf16* O) {
    LAS float* qs = (LAS float*)(F.lds + RING_OFF + F.wave * 4096);
    LAS float* ps = qs + 64;
    const int gw = F.vcu * NWAVES + F.wave, NGW = F.G * NWAVES, lane = F.lane;
    for (int pair = gw; pair < M * NH; pair += NGW) {
        const int tok = pair >> 4, h = pair & 15, t = tok & (SEQ - 1), rowbase = tok - t;
        qs[lane] = bf2f(QKV[(size_t)tok * 3072 + h * 64 + lane]);
        LDS_WAIT(); asm volatile("" ::: "memory");
        float sv[7]; float mx = -1e30f;
#pragma unroll
        for (int rnd = 0; rnd < 7; ++rnd) {
            const int e = rnd * 64 + lane; const int g = e / 129, j = e - g * 129; const int dil = (g == 0) ? 1 : (g == 1) ? 4 : 16; const int tk = t - j * dil;
            float s = -1e30f;
            if (e < 387 && tk >= 0) {
                const GAS v4u* kr = (const GAS v4u*)(QKV + (size_t)(rowbase + tk) * 3072 + 1024 + h * 64);
                float dot = 0.f;
#pragma unroll
                for (int c = 0; c < 8; ++c) { float kf[8]; unpack8(kr[c], kf);
#pragma unroll
                    for (int i = 0; i < 8; ++i) dot += qs[c * 8 + i] * kf[i]; }
                s = dot + rel_bias[t5_bucket(j * dil) * NH + h] * LOG2E;
            }
            sv[rnd] = s; mx = fmaxf(mx, s);
        }
        mx = wave_max(mx);
        float sum = 0.f;
#pragma unroll
        for (int rnd = 0; rnd < 7; ++rnd) { const float p = __builtin_amdgcn_exp2f(sv[rnd] - mx); sum += p; ps[rnd * 64 + lane] = p; }
        sum = wave_sum(sum);
        LDS_WAIT(); asm volatile("" ::: "memory");
        float acc = 0.f;
        for (int g = 0; g < 3; ++g) { const int dil = (g == 0) ? 1 : (g == 1) ? 4 : 16;
            for (int j = 0; j < 129; ++j) { const int tk = t - j * dil; if (tk < 0) break;
                acc += ps[g * 129 + j] * bf2f(QKV[(size_t)(rowbase + tk) * 3072 + 2048 + h * 64 + lane]); } }
        O[(size_t)tok * 1024 + h * 64 + lane] = (bf16)f2bf(acc / sum);
        LDS_WAIT(); asm volatile("" ::: "memory");
    }
}


#ifndef FORCE_SLOWSM
#define FORCE_SLOWSM 0
#endif
namespace att {
constexpr bool FASTSM = (USE_F16 == 0);
typedef short bf16x8 __attribute__((ext_vector_type(8)));
typedef short s16x4 __attribute__((ext_vector_type(4)));
typedef short v4i16_t __attribute__((ext_vector_type(4)));
typedef float f32x16 __attribute__((ext_vector_type(16)));
typedef float f32x2_t __attribute__((ext_vector_type(2))); typedef __bf16 bf16x2_t __attribute__((ext_vector_type(2)));
constexpr int KIMG_OFF = 0, VIMG_OFF = 49152, WL_OFF = 98304, WL_BYTES = 5120, TBL_OFF = WL_OFF + 8 * WL_BYTES;
constexpr int TBL_CP = 208, TBL_G = 4 * TBL_CP;
static_assert(TBL_OFF + 3 * TBL_G * 4 <= LDSCTL_OFF, "attention LDS map");
__device__ __forceinline__ int crow(int r, int hi) { return (r & 3) + 8 * (r >> 2) + 4 * hi; }
__device__ __forceinline__ unsigned cvtpk(float lo, float hi) { return pg8::cvt_pk_bf16(lo, hi); }
#if USE_F16
#define ATT_MFMA32(a, b, c) __builtin_amdgcn_mfma_f32_32x32x16_f16(__builtin_bit_cast(pg8::h16x8, (a)), __builtin_bit_cast(pg8::h16x8, (b)), (c), 0, 0, 0)
#else
#define ATT_MFMA32(a, b, c) __builtin_amdgcn_mfma_f32_32x32x16_bf16((a), (b), (c), 0, 0, 0)
#endif
__device__ __forceinline__ s16x4 vtr(const LAS unsigned char* p) { return __builtin_bit_cast(s16x4, __builtin_amdgcn_ds_read_tr16_b64_v4i16((LAS v4i16_t*)p)); }
__device__ __forceinline__ void build_tables(Frame& F, const float* rel_bias, int h) {
    LAS float* tbl = (LAS float*)(F.lds + TBL_OFF);
    for (int i = F.tid; i < 3 * TBL_G; i += NWAVES * 64) { const int g = i / TBL_G, e = i % TBL_G, s = e / TBL_CP, m = e % TBL_CP; const int n = m + s, rel = 159 - n;
        const int dil = (g == 0) ? 1 : (g == 1) ? 4 : 16;
        tbl[i] = (n < 192 && rel >= 0 && rel <= 128) ? rel_bias[t5_bucket(rel * dil) * NH + h] * LOG2E : -1e30f; }
}
template <int PH>
__device__ __forceinline__ void attn_phase(Frame& F, const bf16* QKV, const float* rel_bias, bf16* MIXp, bf16* O1p, float* LSE) {
    const int bh = F.vcu >> 1, c = F.vcu & 1, b = bh >> 4, h = bh & 15, w = F.wave, lane = F.lane;
    const int c31 = lane & 31, hi = lane >> 5;
    const size_t rowb = (size_t)b * SEQ;
    LAS unsigned char* Kimg = F.lds + KIMG_OFF; LAS unsigned char* Vimg = F.lds + VIMG_OFF;
    LAS unsigned char* wl = F.lds + WL_OFF + w * WL_BYTES;
    LAS float* wsf = (LAS float*)(wl + 4096);
    const LAS float* tblb = (const LAS float*)(F.lds + TBL_OFF);
    constexpr int NCH = (PH == 0) ? 8 : 4;
#define ATT_CHUNK(ci_, g_, resA_, resB_, c0_) do { if (PH == 0) { const int id_ = c + 2 * (ci_); \
            if (id_ < 8) { g_ = 0; resA_ = 0; c0_ = 256 * id_; } else { g_ = 1; resA_ = (id_ - 8) >> 1; c0_ = 256 * (((id_ - 8) & 1) ^ (((id_ - 8) >> 1) & 1)); } resB_ = resA_; } \
        else { const int id_ = c * 4 + (ci_); g_ = 2; resA_ = 2 * id_; resB_ = 2 * id_ + 1; c0_ = 0; } } while (0)
    const int lane_lr = (w < 4) ? 8 * w + (lane >> 3) : 16 * ((w - 4) & 1) + (lane >> 2);
    const int lane_co = (w < 4) ? 1024 + h * 64 + 8 * ((lane & 7) ^ ((4 * (w & 1) + (lane >> 4)) & 7)) : 2048 + h * 64 + 32 * ((w - 4) >> 1) + 8 * (lane & 3);
#define ATT_LOADCHUNK(ci_) do { int g_, ra_, rb_, c0_; ATT_CHUNK(ci_, g_, ra_, rb_, c0_); const int dil_ = (g_ == 0) ? 1 : (g_ == 1) ? 4 : 16; (void)rb_; \
        const size_t stride_ = (size_t)32 * dil_ * 3072; \
        if (PH == 0) { const bf16* base_ = QKV + ((long)rowb + (long)((c0_ - 128 + lane_lr) * dil_ + ra_)) * 3072 + lane_co; \
            if (c0_ != 0) { _Pragma("unroll") for (int i = 0; i < 4; ++i) pre[i] = *(const GAS v4u*)(base_ + i * stride_); } \
            _Pragma("unroll") for (int i = 4; i < 12; ++i) pre[i] = *(const GAS v4u*)(base_ + i * stride_); } \
        else { const bf16* base_ = QKV + (rowb + (size_t)(lane_lr * dil_ + ra_)) * 3072 + lane_co; \
            _Pragma("unroll") for (int i = 4; i < 8; ++i) { pre[i] = *(const GAS v4u*)(base_ + (i - 4) * stride_); pre[i + 4] = *(const GAS v4u*)(base_ + 3072 + (i - 4) * stride_); } } } while (0)
    v4u pre[12];
#define ATT_LOADQ(ci_) do { int g_, ra_, rb_, c0_; ATT_CHUNK(ci_, g_, ra_, rb_, c0_); const int dil_ = (g_ == 0) ? 1 : (g_ == 1) ? 4 : 16; \
        const int res_ = (PH == 1 && w >= 4) ? rb_ : ra_; const int m0_ = (PH == 1) ? 32 * ((w < 4) ? w : 7 - w) : c0_ + 32 * w; \
        const bf16* qp_ = QKV + (rowb + (size_t)((m0_ + c31) * dil_ + res_)) * 3072 + h * 64 + 8 * hi; \
        _Pragma("unroll") for (int s = 0; s < 4; ++s) qf[s] = *(const bf16x8*)(qp_ + 16 * s); } while (0)
    ATT_LOADCHUNK(0);
    if (PH == 0) build_tables(F, rel_bias, h);
    for (int ci = 0; ci < NCH; ++ci) {
        int g, resA, resB, c0; ATT_CHUNK(ci, g, resA, resB, c0);
        const int dil = (g == 0) ? 1 : (g == 1) ? 4 : 16;
        const int res = (PH == 1 && w >= 4) ? resB : resA;
        const int m0 = (PH == 1) ? 32 * ((w < 4) ? w : 7 - w) : c0 + 32 * w;
        const int tb0 = (PH == 1) ? ((w < 4) ? 0 : 4) + (m0 >> 5) : w;
        const int nskip = (m0 >= 128) ? 0 : 4 - (m0 >> 5);
        bf16x8 qf[4]; ATT_LOADQ(ci);
        __syncthreads();
        { LAS unsigned char* dst = ((w < 4) ? Kimg + w * 1024 : Vimg + (w - 4) * 1024) + lane * 16;
          if (PH == 0 && c0 != 0) {
#pragma unroll
            for (int i = 0; i < 4; ++i) *(LAS v4u*)(dst + i * 4096) = pre[i]; }
#pragma unroll
          for (int i = 4; i < 12; ++i) *(LAS v4u*)(dst + i * 4096) = pre[i]; }
        const int tq = (m0 + c31) * dil + res;
        float l0n = 0.f, l1n = 0.f;
        if (PH == 1) { l0n = LSE[(rowb + tq) * NH + h]; l1n = LSE[((size_t)M + rowb + tq) * NH + h]; }
        LDS_WAIT();
        __syncthreads();
        if (ci + 1 < NCH) ATT_LOADCHUNK(ci + 1);
        float mx = 0.f, ls = 0.f;
        f32x16 o[2];
        float zacc = 0.f; asm volatile("" : "+v"(zacc));
#pragma unroll
        for (int r = 0; r < 16; ++r) { o[0][r] = zacc; o[1][r] = zacc; }
        const int loff = ((lane >> 4) & 1) * 32 + (lane & 3) * 8 + (4 * hi + ((lane & 15) >> 2)) * 64;
        const int ta = 31 - c31 + 4 * hi, ts = ta & 3; const LAS f32x4* tb = (const LAS f32x4*)(tblb + g * TBL_G + ts * TBL_CP + (ta - ts));
        const LAS unsigned char* kbase = Kimg + tb0 * 4096 + c31 * 128; const LAS unsigned char* vbase = Vimg + tb0 * 4096;
#define ATT_QK(dst, kt_) do { const LAS f32x4* tq_ = tb + 8 * (kt_); _Pragma("unroll") for (int j = 0; j < 4; ++j) { const f32x4 t4 = tq_[2 * j]; dst[4 * j + 0] = t4[0]; dst[4 * j + 1] = t4[1]; dst[4 * j + 2] = t4[2]; dst[4 * j + 3] = t4[3]; } \
                const LAS unsigned char* kp_ = kbase + (kt_) * 4096; \
                _Pragma("unroll") for (int s = 0; s < 4; ++s) { const bf16x8 kf = *(const LAS bf16x8*)(kp_ + (((2 * s + hi) ^ ((c31 >> 1) & 7)) << 4)); dst = ATT_MFMA32(kf, qf[s], dst); } } while (0)
#define ATT_PV(a_, kt_) do { const LAS unsigned char* slot = vbase + (kt_) * 4096; \
                _Pragma("unroll") for (int ks = 0; ks < 2; ++ks) { \
                    v4u pw; pw.x = cvtpk(a_[8 * ks + 0], a_[8 * ks + 1]); pw.y = cvtpk(a_[8 * ks + 2], a_[8 * ks + 3]); pw.z = cvtpk(a_[8 * ks + 4], a_[8 * ks + 5]); pw.w = cvtpk(a_[8 * ks + 6], a_[8 * ks + 7]); \
                    const bf16x8 pa = __builtin_bit_cast(bf16x8, pw); \
                    osum = ATT_MFMA32(ones, pa, osum); \
                    _Pragma("unroll") for (int dh = 0; dh < 2; ++dh) { \
                        const s16x4 lo = vtr(slot + (dh * 2 + ks) * 1024 + loff), hh = vtr(slot + (dh * 2 + ks) * 1024 + loff + 512); \
                        const bf16x8 vb = (bf16x8){lo[0], lo[1], lo[2], lo[3], hh[0], hh[1], hh[2], hh[3]}; \
                        o[dh] = ATT_MFMA32(pa, vb, o[dh]); } } } while (0)
        f32x16 osum;
#pragma unroll
        for (int r = 0; r < 16; ++r) osum[r] = zacc;
        bf16x8 ones = (bf16x8){(short)0x3F80, (short)0x3F80, (short)0x3F80, (short)0x3F80, (short)0x3F80, (short)0x3F80, (short)0x3F80, (short)0x3F80};
        asm volatile("" : "+v"(ones));
        if (FASTSM) {
            int kt = 4; f32x16 an; ATT_QK(an, 4);
            for (;;) {
                f32x16 a = an;
                const int kn = (kt > nskip) ? kt - 1 : kt;
                ATT_QK(an, kn);
#pragma unroll
                for (int r = 0; r < 16; ++r) a[r] = __builtin_amdgcn_exp2f(a[r]);
                ATT_PV(a, kt);
                if (kt == nskip) break;
                --kt;
            }
            ls = osum[0];
        }
        { const float lt = ls;
          const bool redo = !FASTSM || FORCE_SLOWSM || !(lt > 1e-30f && lt < 1e30f);
          if (__builtin_expect(__any(redo), !FASTSM || FORCE_SLOWSM)) {
            mx = -1e30f;
            for (int kt = 4; kt >= nskip; --kt) { f32x16 a; ATT_QK(a, kt);
#pragma unroll
                for (int r = 0; r < 16; ++r) mx = fmaxf(mx, a[r]); }
            mx = fmaxf(mx, __shfl_xor(mx, 32));
            { float z = 0.f; asm volatile("" : "+v"(z));
#pragma unroll
              for (int r = 0; r < 16; ++r) { o[0][r] = z; o[1][r] = z; osum[r] = z; } }
            for (int kt = 4; kt >= nskip; --kt) { f32x16 a; ATT_QK(a, kt);
#pragma unroll
                for (int r = 0; r < 16; ++r) a[r] = __builtin_amdgcn_exp2f(a[r] - mx);
                ATT_PV(a, kt); }
            ls = osum[0];
          }
        }
#undef ATT_QK
#undef ATT_PV
        v4u m0w[4], o1w[4];
        if (PH == 1) {
#pragma unroll
            for (int i = 0; i < 4; ++i) { const int row = i * 8 + (lane >> 3), ch = lane & 7;
                const size_t off = (rowb + (size_t)((m0 + row) * dil + res)) * 1024 + h * 64 + ch * 8;
                m0w[i] = *(const GAS v4u*)(MIXp + off); o1w[i] = *(const GAS v4u*)(O1p + off); }
        }
        if (hi == 0) wsf[c31] = __builtin_amdgcn_rcpf(ls);
        float a0w = 0.f, a1w = 0.f, a2w = 0.f;
        if (PH == 1) {
            const float l2 = mx + __builtin_amdgcn_logf(ls), l0 = l0n, l1 = l1n;
            const float mm = fmaxf(l2, fmaxf(l0, l1)); const float w0 = __builtin_amdgcn_exp2f(l0 - mm), w1 = __builtin_amdgcn_exp2f(l1 - mm), w2 = __builtin_amdgcn_exp2f(l2 - mm);
            const float iw = __builtin_amdgcn_rcpf(w0 + w1 + w2);
            if (hi == 0) { wsf[32 + 3 * c31 + 0] = w0 * iw; wsf[32 + 3 * c31 + 1] = w1 * iw; wsf[32 + 3 * c31 + 2] = w2 * iw; }
        }
        LDS_WAIT(); asm volatile("" ::: "memory");
        LAS bf16* stg = (LAS bf16*)wl;
#pragma unroll
        for (int r = 0; r < 16; ++r) { const int qr = crow(r, hi); const float rl = wsf[qr];
            const unsigned pk = cvtpk(o[0][r] * rl, o[1][r] * rl);
            stg[qr * 64 + c31] = (bf16)(pk & 0xffffu); stg[qr * 64 + 32 + c31] = (bf16)(pk >> 16); }
        LDS_WAIT(); asm volatile("" ::: "memory");
        if (PH == 0) {
            bf16* Odst = (g == 0) ? MIXp : O1p;
#pragma unroll
            for (int i = 0; i < 4; ++i) { const int row = i * 8 + (lane >> 3), ch = lane & 7; const v4u v = *(const LAS v4u*)(stg + row * 64 + ch * 8);
                *(GAS v4u*)(Odst + (rowb + (size_t)((m0 + row) * dil + res)) * 1024 + h * 64 + ch * 8) = v; }
            if (hi == 0) LSE[((size_t)g * M + rowb + tq) * NH + h] = mx + __builtin_amdgcn_logf(ls);
        } else {
#pragma unroll
            for (int i = 0; i < 4; ++i) { const int row = i * 8 + (lane >> 3), ch = lane & 7;
                a0w = wsf[32 + 3 * row + 0]; a1w = wsf[32 + 3 * row + 1]; a2w = wsf[32 + 3 * row + 2];
                const size_t off = (rowb + (size_t)((m0 + row) * dil + res)) * 1024 + h * 64 + ch * 8;
                float f0[8], f1[8], f2[8]; unpack8(m0w[i], f0); unpack8(o1w[i], f1); unpack8(*(const LAS v4u*)(stg + row * 64 + ch * 8), f2);
                float y[8];
#pragma unroll
                for (int e = 0; e < 8; ++e) y[e] = a0w * f0[e] + a1w * f1[e] + a2w * f2[e];
                v4u ov; ov.x = pk2(y[0], y[1]); ov.y = pk2(y[2], y[3]); ov.z = pk2(y[4], y[5]); ov.w = pk2(y[6], y[7]);
                *(GAS v4u*)(MIXp + off) = ov; }
        }
        LDS_WAIT(); asm volatile("" ::: "memory");
    }
    __syncthreads();
#undef ATT_CHUNK
#undef ATT_LOADCHUNK
#undef ATT_LOADQ
}
}

__device__ __forceinline__ void final_norm_pass(Frame& F, const bf16* xb, const float* g, float* out) {
    const int gw = F.vcu * NWAVES + F.wave;
    f32x4 gv[4];
#pragma unroll
    for (int q = 0; q < 2; ++q) { gv[2 * q] = ((const GAS f32x4*)g)[128 * q + 2 * F.lane]; gv[2 * q + 1] = ((const GAS f32x4*)g)[128 * q + 2 * F.lane + 1]; }
    v4u xw[8][2];
#pragma unroll
    for (int kk = 0; kk < 8; ++kk) { const int m = SEQ * (gw >> 8) + (gw & 255) + 256 * kk; const GAS v4u* xr = (const GAS v4u*)(xb + (size_t)m * D) + F.lane; xw[kk][0] = xr[0]; xw[kk][1] = xr[64]; }
#pragma unroll
    for (int kk = 0; kk < 8; ++kk) { const int m = SEQ * (gw >> 8) + (gw & 255) + 256 * kk;
        float v[2][8]; float s = 0.f;
#pragma unroll
        for (int q = 0; q < 2; ++q) { unpack8(xw[kk][q], v[q]);
#pragma unroll
            for (int e = 0; e < 8; ++e) s += v[q][e] * v[q][e]; }
        const float rstd = 1.0f / sqrtf(wave_sum(s) * (1.0f / D) + 1e-6f);
        GAS f32x4* o = (GAS f32x4*)(out + (size_t)m * D);
#pragma unroll
        for (int q = 0; q < 2; ++q) {
            __builtin_nontemporal_store((f32x4){v[q][0], v[q][1], v[q][2], v[q][3]} * rstd * gv[2 * q], &o[128 * q + 2 * F.lane]);
            __builtin_nontemporal_store((f32x4){v[q][4], v[q][5], v[q][6], v[q][7]} * rstd * gv[2 * q + 1], &o[128 * q + 2 * F.lane + 1]); }
    }
}


constexpr int RSTD_OFF = RING_BYTES;
constexpr int XPOSE_OFF = RSTD_OFF + 6144;
static_assert(XPOSE_OFF + 8 * 2048 <= LDSCTL_OFF, "epilogue turn slots");
struct RstdOrder : pg8::StaticOrder {
    float p[3][4]; LAS float* tab; int tid;
    __device__ __forceinline__ void load(Frame& F, const float* ssq) {
        tab = (LAS float*)(F.lds + RSTD_OFF); tid = F.tid;
        pg8::Unit u;
#pragma unroll
        for (int k = 0; k < 3; ++k) { const int ui = 2 * k + (tid >> 8);
            if (next(ui, u)) { const int row = u.pm * 256 + (tid & 255);
#pragma unroll
                for (int q = 0; q < 4; ++q) p[k][q] = ssq[(size_t)q * M + row]; }
            else {
#pragma unroll
                for (int q = 0; q < 4; ++q) p[k][q] = 1.0f; } }
    }
    __device__ __forceinline__ void after_first_stage() const {
#pragma unroll
        for (int k = 0; k < 3; ++k) tab[(2 * k + (tid >> 8)) * 256 + (tid & 255)] = __builtin_amdgcn_rsqf(((p[k][0] + p[k][1]) + (p[k][2] + p[k][3])) * (1.0f / 1024.0f) + 1e-6f);
    }
};

#define CONV_FLAG(j, pm) (8192 + 1024 * (j) + 16 * (pm))
struct ConvOrder {
    pg8::StaticOrder Scu, Sb; float p[3][4]; LAS float* tab; int tid;
    __device__ __forceinline__ void init(int G, int c) { Scu.init(M, 2048, G, c); Sb.init(M, 1024, G, c); }
    __device__ __forceinline__ bool next(int ui, pg8::Unit& u) const {
        if (ui < 2) { if (!Scu.next(ui, u)) return false; u.pn += 4; u.ord = ui; return true; }
        if (ui == 2) { if (!Sb.next(0, u)) return false; u.ord = 2; return true; }
        return false;
    }
    __device__ __forceinline__ void load(Frame& F, const float* ssq) {
        tab = (LAS float*)(F.lds + RSTD_OFF); tid = F.tid;
        pg8::Unit u;
#pragma unroll
        for (int k = 0; k < 3; ++k) { const int ui = 2 * k + (tid >> 8);
            if (next(ui, u)) { const int row = u.pm * 256 + (tid & 255);
#pragma unroll
                for (int q = 0; q < 4; ++q) p[k][q] = ssq[(size_t)q * M + row]; }
            else {
#pragma unroll
                for (int q = 0; q < 4; ++q) p[k][q] = 1.0f; } }
    }
    __device__ __forceinline__ void after_first_stage() const {
#pragma unroll
        for (int k = 0; k < 3; ++k) tab[(2 * k + (tid >> 8)) * 256 + (tid & 255)] = __builtin_amdgcn_rsqf(((p[k][0] + p[k][1]) + (p[k][2] + p[k][3])) * (1.0f / 1024.0f) + 1e-6f);
    }
    __device__ __forceinline__ void a_ready(const pg8::Unit&) const {}
    __device__ __forceinline__ void done(const pg8::Unit&) const {}
};
namespace pg8 {
struct EpiConvFused {
    static constexpr bool PERM = true, AFTER_DRAIN = false, LAST_DRAINED = true;
    bf16_t* CU; bf16_t* MX; const float* ck; const PG8_LAS float* rs; PG8_LAS unsigned char* stg; unsigned* bar; int jl;
    __device__ __forceinline__ void operator()(const f32x4 (&acc)[2][2][4][2], const Unit& u, int wr, int wc, int fr, int fq) const {
        XPOSE_SETUP(stg, wr, wc, fr, fq);
        const int row0 = u.pm * BM + wr * 64 + xp_tr, col0 = (u.pn - 4) * HALF + wc * 32 + 8 * xp_tc;
#pragma unroll
        for (int ai = 0; ai < 2; ++ai)
#pragma unroll
            for (int m = 0; m < 4; ++m) { const int row = row0 + ai * HALF + m * 16; const float rs = this->rs[u.ord * BM + ai * HALF + wr * 64 + m * 16 + fr]; const float rs2 = rs * rs;
                *(u32x4*)(CU + (size_t)row * 1024 + col0) = XPOSE_TURN(m & 1, pack8(acc[ai][0][m][0] * acc[ai][1][m][0] * rs2, acc[ai][0][m][1] * acc[ai][1][m][1] * rs2)); }
        asm volatile("s_waitcnt vmcnt(0)" ::: "memory");
        if (xp_lane == 0) xb_add(&bar[CONV_FLAG(jl, u.pm)], 1u);
    }
    __device__ __forceinline__ void fused(const f32x4 (&acc)[2][2][4][2], const Unit& u, int wr, int wc, int fr, int fq, PG8_LAS unsigned char* lds, int wid, int lane) const {
#pragma unroll
        for (int ai = 0; ai < 2; ++ai)
#pragma unroll
            for (int m = 0; m < 4; ++m) { const int row = ai * HALF + wr * 64 + m * 16 + fr; const float rs = this->rs[u.ord * BM + row];
#pragma unroll
                for (int bj = 0; bj < 2; ++bj) { const int chunk = bj * 16 + wc * 4 + fq;
                    *(PG8_LAS u32x4*)(lds + row * 512 + ((chunk ^ (row & 31)) << 4)) = pack8(acc[ai][bj][m][0] * rs, acc[ai][bj][m][1] * rs); } }
        if (lane == 0) {
            XB_SPIN(xb_ld(&bar[CONV_FLAG(jl, u.pm)]) < 64u, bar);
            if ((u.pm & 7) != 0) XB_SPIN(xb_ld(&bar[CONV_FLAG(jl, u.pm - 1)]) < 64u, bar);
        }
        __builtin_amdgcn_fence(__ATOMIC_ACQUIRE, "agent");
        asm volatile("s_waitcnt lgkmcnt(0)" ::: "memory"); __builtin_amdgcn_s_barrier(); asm volatile("" ::: "memory");
        const int t = wid * 64 + lane, c = t & 31, r0 = (t >> 5) * 16, t0 = u.pm * BM + r0, col = u.pn * BM + 8 * c;
        f32x4 kt[3][2];
#pragma unroll
        for (int d = 0; d < 3; ++d) { kt[d][0] = *(const f32x4*)(ck + d * 1024 + col); kt[d][1] = *(const f32x4*)(ck + d * 1024 + col + 4); }
        u32x4 cw[16], h2, h1;
        if ((t0 & 2047) != 0) { h2 = *(const u32x4*)(CU + (size_t)(t0 - 2) * 1024 + col); h1 = *(const u32x4*)(CU + (size_t)(t0 - 1) * 1024 + col); }
        else { h2.x = 0u; h2.y = 0u; h2.z = 0u; h2.w = 0u; h1 = h2; }
#pragma unroll
        for (int r = 0; r < 16; ++r) cw[r] = *(const u32x4*)(CU + (size_t)(t0 + r) * 1024 + col);
        f32x4 p2a, p2b, p1a, p1b; unpack8f(h2, p2a, p2b); unpack8f(h1, p1a, p1b);
#pragma unroll
        for (int r = 0; r < 16; ++r) { const int row = r0 + r;
            f32x4 xa, xb_, ba, bb; unpack8f(cw[r], xa, xb_);
            unpack8f(*(const PG8_LAS u32x4*)(lds + row * 512 + ((c ^ (row & 31)) << 4)), ba, bb);
            const f32x4 za = kt[0][0] * p2a + kt[1][0] * p1a + kt[2][0] * xa, zb = kt[0][1] * p2b + kt[1][1] * p1b + kt[2][1] * xb_;
            *(u32x4*)(MX + (size_t)(t0 + r) * 1024 + col) = pack8(ba * za, bb * zb);
            p2a = p1a; p2b = p1b; p1a = xa; p1b = xb_; }
    }
};
}

struct EpiResFinal {
    static constexpr bool PERM = true, AFTER_DRAIN = true, LAST_DRAINED = false;
    const bf16* xb; float* ssq; const float* gfin; float* out; const XcdBarrier* bar; unsigned* lseq; bool local_mode; bool do_final;
    __device__ __forceinline__ void fused(pg8::f32x4 (&acc)[2][2][4][2], const pg8::Unit& u, int wr, int wc, int fr, int fq, LAS unsigned char* lds, int wid, int lane) const {
        LAS float* Pt = (LAS float*)lds;
        LAS float* Rt = (LAS float*)(lds + 4096);
        const int col0 = u.pn * 256 + wc * 32 + 8 * fq;
        pg8::u32x4 xr[2][4][2];
#pragma unroll
        for (int ai = 0; ai < 2; ++ai)
#pragma unroll
            for (int m = 0; m < 4; ++m) { const size_t off = (size_t)(u.pm * 256 + ai * 128 + wr * 64 + m * 16 + fr) * 1024 + col0;
#pragma unroll
                for (int bj = 0; bj < 2; ++bj) xr[ai][m][bj] = *(const pg8::u32x4*)(xb + off + bj * 128); }
#pragma unroll
        for (int ai = 0; ai < 2; ++ai)
#pragma unroll
            for (int m = 0; m < 4; ++m) { const int rl = ai * 128 + wr * 64 + m * 16 + fr; float s = 0.f;
#pragma unroll
                for (int bj = 0; bj < 2; ++bj) { pg8::f32x4 x0, x1; pg8::unpack8f(xr[ai][m][bj], x0, x1);
                    const pg8::f32x4 v0 = acc[ai][bj][m][0] + x0, v1 = acc[ai][bj][m][1] + x1;
                    acc[ai][bj][m][0] = v0; acc[ai][bj][m][1] = v1;
                    s += (v0[0] * v0[0] + v0[1] * v0[1]) + (v0[2] * v0[2] + v0[3] * v0[3]) + (v1[0] * v1[0] + v1[1] * v1[1]) + (v1[2] * v1[2] + v1[3] * v1[3]); }
                s += __shfl_xor(s, 16); s += __shfl_xor(s, 32);
                if (fq == 0) Pt[rl * 4 + wc] = s; }
        LDS_WAIT(); __syncthreads();
        const int t = wid * 64 + lane;
        if (t < 256) { const pg8::f32x4 p = *(const LAS pg8::f32x4*)(Pt + t * 4); ssq[(size_t)u.pn * M + u.pm * 256 + t] = (p[0] + p[1]) + (p[2] + p[3]); }
        if (!do_final) return;
        if (local_mode) xcc_local_barrier(*bar, *lseq); else xcd_barrier(*bar);
        if (t < 256) { const int row = u.pm * 256 + t;
            const float sq = (ssq[row] + ssq[(size_t)M + row]) + (ssq[(size_t)2 * M + row] + ssq[(size_t)3 * M + row]);
            Rt[t] = 1.0f / sqrtf(sq * (1.0f / D) + 1e-6f); }
        pg8::f32x4 gv[2][2];
#pragma unroll
        for (int bj = 0; bj < 2; ++bj) { gv[bj][0] = *(const GAS pg8::f32x4*)(gfin + col0 + bj * 128); gv[bj][1] = *(const GAS pg8::f32x4*)(gfin + col0 + bj * 128 + 4); }
        LDS_WAIT(); __syncthreads();
#pragma unroll
        for (int ai = 0; ai < 2; ++ai)
#pragma unroll
            for (int m = 0; m < 4; ++m) { const int rl = ai * 128 + wr * 64 + m * 16 + fr; const float rs = Rt[rl];
                float* orow = out + (size_t)(u.pm * 256 + rl) * 1024 + col0;
#pragma unroll
                for (int bj = 0; bj < 2; ++bj) {
                    __builtin_nontemporal_store(acc[ai][bj][m][0] * rs * gv[bj][0], (GAS pg8::f32x4*)(orow + bj * 128));
                    __builtin_nontemporal_store(acc[ai][bj][m][1] * rs * gv[bj][1], (GAS pg8::f32x4*)(orow + bj * 128 + 4)); } }
    }
};

#ifndef ATTN_SIMPLE
#define ATTN_SIMPLE 0
#endif
#ifndef DUP_G1
#define DUP_G1 0
#endif
#ifndef DUP_G3
#define DUP_G3 0
#endif
#ifndef DUP_P0
#define DUP_P0 0
#endif
#ifndef DUP_BAR
#define DUP_BAR 0
#endif
#ifndef NO_LOCAL
#define NO_LOCAL 0
#endif
#ifndef DUP_ATT
#define DUP_ATT 0
#endif
#ifndef DUP_CONV
#define DUP_CONV 0
#endif
constexpr int NPHASE = 2 + 6 * DEPTH;
struct Args { const float* in[13]; float* out; unsigned char* ws; int ph_lo, ph_hi; };
__global__ void __launch_bounds__(NWAVES * 64, 2) mk_fwd(Args args) {
    extern __shared__ __attribute__((aligned(16))) unsigned char lds[];
    Frame F;
    F.lds = (LAS unsigned char*)lds;
    F.MISC = (volatile LAS unsigned*)(F.lds + MISC_OFF);
    F.tid = threadIdx.x; F.lane = F.tid & 63; F.wave = __builtin_amdgcn_readfirstlane(F.tid >> 6);
    F.G = gridDim.x; { const int bx = blockIdx.x; F.vcu = (F.G % 8 == 0) ? (bx % 8) * (F.G / 8) + bx / 8 : bx; }
    unsigned char* ws = args.ws;
    F.ctl = (gu32*)(ws + WS_CTL);
    Ptrs P;
    P.x = args.in[0]; P.mix_norm = args.in[1]; P.ffn_norm = args.in[2]; P.final_norm = args.in[3]; P.conv_w_in = args.in[4]; P.conv_kernel = args.in[5]; P.conv_w_out = args.in[6];
    P.attn_w_qkv = args.in[7]; P.attn_w_out = args.in[8]; P.rel_bias = args.in[9]; P.w_gate = args.in[10]; P.w_up = args.in[11]; P.w_down = args.in[12]; P.out = args.out; P.ws = ws;
    for (int u = F.tid; u < (LDS_BYTES - LDSCTL_OFF) / 4; u += NWAVES * 64) ((LAS unsigned*)(F.lds + LDSCTL_OFF))[u] = 0u;
    __syncthreads();
    XcdBarrier bar = xcd_barrier_post((unsigned*)(F.ctl + CW_BAR), F.MISC + 8);
    int cid = (int)blockIdx.x;
    bool local_mode = false; unsigned lseq = 0u;
    bf16* XB = (bf16*)(ws + WS_XB); float* SSQ = (float*)(ws + WS_SSQ); bf16* ACT = (bf16*)(ws + WS_ACT); bf16* MIX = (bf16*)(ws + WS_MIX);
    const int lo = args.ph_lo, hi = args.ph_hi;
#define IN(k) (lo <= (k) && (k) < hi)
#if DUP_G1
#define REPG1(...) { __VA_ARGS__ __VA_ARGS__ }
#else
#define REPG1(...) __VA_ARGS__
#endif
#if DUP_G3
#define REPG3(...) { __VA_ARGS__ __VA_ARGS__ }
#else
#define REPG3(...) __VA_ARGS__
#endif
#if DUP_ATT
#define REPATT(...) { __VA_ARGS__ __syncthreads(); __VA_ARGS__ }
#else
#define REPATT(...) __VA_ARGS__
#endif
#if DUP_CONV
#define REPCONV(...) { __VA_ARGS__ __syncthreads(); __VA_ARGS__ }
#else
#define REPCONV(...) __VA_ARGS__
#endif
#define SEAMG(k) do { if (IN(k) && IN((k) + 1)) { xcd_barrier(bar); if (DUP_BAR) xcd_barrier(bar); } } while (0)
#define SEAM(k) do { if (IN(k) && IN((k) + 1)) { if (local_mode) xcc_local_barrier(bar, lseq); else xcd_barrier(bar); if (DUP_BAR) { if (local_mode) xcc_local_barrier(bar, lseq); else xcd_barrier(bar); } } } while (0)
    if (IN(0)) { p0_prologue(F, P); if (DUP_P0) { __syncthreads(); p0_prologue(F, P); } } SEAMG(0);
    if (lo == 0 && hi == NPHASE && F.G == 256 && !NO_LOCAL) {
        if (F.tid == 0) { unsigned ok = 1u;
#pragma unroll
            for (unsigned jx = 0; jx < 16; ++jx) { const unsigned cx = xb_ld(&bar.bar[XB_XCNT(jx)]); ok &= (cx == (jx < 8u ? 32u : 0u)) ? 1u : 0u; }
            F.MISC[11] = ok; }
        __syncthreads();
        local_mode = F.MISC[11] != 0u;
        if (local_mode) { const int rank = (int)F.MISC[10], xcc = (int)bar.x; cid = rank * 8 + xcc; F.vcu = xcc * 32 + rank; }
    }
    const bool conv_fused = local_mode && F.G == 256 && IN(0) && IN(NPHASE - 1);
#define LAYER(li) do { \
        constexpr int j = (li) >> 1; constexpr bool is_attn = ((li) & 1) != 0; constexpr int p0 = 1 + 6 * (li); \
        const unsigned char* wl = ws + WS_W + (size_t)(li) * W_LAYER; \
        if (IN(p0) && (is_attn || !conv_fused)) REPG1({ pg8::Gemm g{XB, (const bf16*)(wl + W_IN_OFF), M, 3072, 1024}; RstdOrder S; S.init(M, 3072, F.G, cid); S.load(F, SSQ); \
            if (is_attn) { pg8::EpiQKV E{ACT, (const LAS float*)(F.lds + RSTD_OFF), C2, F.lds + XPOSE_OFF}; pg8::gemm_phase<pg8::EpiQKV, RstdOrder, true, true>(F.lds + RING_OFF, g, S, E); } \
            else { pg8::EpiConvIn E{ACT, ACT + (size_t)M * 1024, (const LAS float*)(F.lds + RSTD_OFF), F.lds + XPOSE_OFF}; pg8::gemm_phase<pg8::EpiConvIn, RstdOrder, true, true>(F.lds + RING_OFF, g, S, E); } }) \
        if (!is_attn && conv_fused) { if (IN(p0)) { pg8::Gemm g{XB, (const bf16*)(wl + W_IN_OFF), M, 3072, 1024}; ConvOrder S; S.init(F.G, cid); S.load(F, SSQ); \
                pg8::EpiConvFused E{ACT + (size_t)M * 1024, MIX, P.conv_kernel + (size_t)j * 3 * 1024, (const LAS float*)(F.lds + RSTD_OFF), F.lds + XPOSE_OFF, bar.bar, j}; \
                pg8::gemm_phase<pg8::EpiConvFused, ConvOrder, true, true>(F.lds + RING_OFF, g, S, E); } } \
        else { SEAM(p0); \
        if (IN(p0 + 1)) { if (is_attn) REPATT({ if (ATTN_SIMPLE) attn_simple(F, ACT, P.rel_bias, MIX); else att::attn_phase<0>(F, ACT, P.rel_bias, MIX, (bf16*)P.out, (float*)((char*)P.out + 32 * MiB)); }) \
                          else REPCONV({ conv_pass(F, ACT, ACT + (size_t)M * 1024, P.conv_kernel + (size_t)j * 3 * 1024, MIX); }) } } \
        SEAM(p0 + 1); \
        if (is_attn && !ATTN_SIMPLE) { if (IN(p0 + 2)) att::attn_phase<1>(F, ACT, P.rel_bias, MIX, (bf16*)P.out, (float*)((char*)P.out + 32 * MiB)); SEAM(p0 + 2); } \
        if (IN(p0 + 3)) { pg8::Gemm g{MIX, (const bf16*)(wl + W_OUT_OFF), M, 1024, 1024}; pg8::StaticOrder S; S.init(M, 1024, F.G, cid); \
            pg8::EpiRes E{XB, SSQ}; pg8::gemm_phase<pg8::EpiRes, pg8::StaticOrder, false, true>(F.lds + RING_OFF, g, S, E); } \
        SEAM(p0 + 3); \
        if (IN(p0 + 4)) { if ((li) + 1 < DEPTH && cid >= 128) { convert_layer_weights(F, P, (li) + 1, (cid - 128) * NWAVES + F.wave, 128 * NWAVES, 1); __syncthreads(); } } \
        if (IN(p0 + 4)) REPG3({ pg8::Gemm g{XB, (const bf16*)(wl + W_GU_OFF), M, 5632, 1024}; RstdOrder S; S.init(M, 5632, F.G, cid); S.load(F, SSQ); \
            pg8::EpiSwiGLU E{ACT, (const LAS float*)(F.lds + RSTD_OFF), F.lds + XPOSE_OFF}; pg8::gemm_phase<pg8::EpiSwiGLU, RstdOrder, true, true>(F.lds + RING_OFF, g, S, E); }) \
        if (IN(p0 + 4)) { if ((li) + 1 < DEPTH && cid >= 128) { __syncthreads(); convert_layer_weights(F, P, (li) + 1, (cid - 128) * NWAVES + F.wave, 128 * NWAVES, 2); } } \
        SEAM(p0 + 4); \
        if (IN(p0 + 5)) { pg8::Gemm g{ACT, (const bf16*)(wl + W_DN_OFF), M, 1024, 2816}; pg8::StaticOrder S; S.init(M, 1024, F.G, cid); \
            if ((li) + 1 < DEPTH) { pg8::EpiRes E{XB, SSQ}; pg8::gemm_phase<pg8::EpiRes, pg8::StaticOrder, false, true>(F.lds + RING_OFF, g, S, E); } \
            else { EpiResFinal E{XB, SSQ, P.final_norm, P.out, &bar, &lseq, local_mode, IN(NPHASE - 1)}; pg8::gemm_phase<EpiResFinal, pg8::StaticOrder, false, true>(F.lds + RING_OFF, g, S, E); } } \
        if ((li) + 1 < DEPTH) SEAMG(p0 + 5); \
    } while (0)
    LAYER(0); LAYER(1); LAYER(2); LAYER(3);
}

#ifndef MK_PER_PHASE
#define MK_PER_PHASE 0
#endif
extern "C" void kernel_launch(void* const* d_in, const int* in_sizes, int n_in, void* d_out, int out_size, void* d_ws, size_t ws_size, hipStream_t stream) {
    static int grid = 0;
    if (grid == 0) {
        if (n_in != 13 || in_sizes[0] != M * D || out_size != M * D || ws_size < WS_END) { fprintf(stderr, "kernel_launch: unexpected shapes (n_in %d, in0 %d, out %d, ws %zu)\n", n_in, n_in > 0 ? in_sizes[0] : -1, out_size, ws_size); grid = -1; return; }
        int dev = 0, cus = 0, per_cu = 0;
        if (hipGetDevice(&dev) != hipSuccess || hipDeviceGetAttribute(&cus, hipDeviceAttributeMultiprocessorCount, dev) != hipSuccess) { grid = -1; return; }
        if (hipFuncSetAttribute((const void*)mk_fwd, hipFuncAttributeMaxDynamicSharedMemorySize, LDS_BYTES) != hipSuccess) { fprintf(stderr, "kernel_launch: hipFuncSetAttribute failed\n"); grid = -1; return; }
        if (hipOccupancyMaxActiveBlocksPerMultiprocessor(&per_cu, (const void*)mk_fwd, NWAVES * 64, LDS_BYTES) != hipSuccess || per_cu < 1) { fprintf(stderr, "kernel_launch: occupancy query says %d blocks per CU\n", per_cu); (void)hipGetLastError(); grid = -1; return; }
        grid = cus;
        if (grid != 256) fprintf(stderr, "kernel_launch: %d CUs; this kernel is laid out for 256\n", grid);
    }
    if (grid < 0) return;
    (void)hipMemsetAsync((char*)d_ws + WS_CTL, 0, CTL_ZERO_BYTES, stream);
    Args a{};
    for (int i = 0; i < 13; ++i) a.in[i] = (const float*)d_in[i];
    a.out = (float*)d_out; a.ws = (unsigned char*)d_ws;
#if MK_PER_PHASE
    for (int ph = 0; ph < NPHASE; ++ph) { a.ph_lo = ph; a.ph_hi = ph + 1; hipLaunchKernelGGL(mk_fwd, dim3(grid), dim3(NWAVES * 64), LDS_BYTES, stream, a); }
#else
    a.ph_lo = 0; a.ph_hi = NPHASE;
    hipLaunchKernelGGL(mk_fwd, dim3(grid), dim3(NWAVES * 64), LDS_BYTES, stream, a);
#endif
}
```

```cpp
#include <hip/hip_runtime.h>
#include <cstdio>
#include <cstdint>
namespace pg8 {
#define PG8_LAS __attribute__((address_space(3)))
typedef unsigned short bf16_t;
typedef short bf16x8 __attribute__((ext_vector_type(8)));
typedef float f32x4 __attribute__((ext_vector_type(4)));
typedef unsigned u32x4 __attribute__((ext_vector_type(4)));
constexpr int BM = 256, BK = 64, HALF = 128, HTB = HALF * BK * 2  , STAGE_BYTES = 8 * HTB, NXCD = 8, WGM = 4;

__host__ __device__ __forceinline__ int lds_byte(int r, int c) { const int st = (r >> 4) * 2 + (c >> 5), rr = r & 15, cc = c & 31, ob = rr * 64 + cc * 2; return st * 1024 + (ob ^ (((ob >> 9) & 1) << 5)); }
__host__ __device__ __forceinline__ void stage_rc(int b, int& R, int& C) { const int st = b / 1024, sb = b % 1024, swz = sb ^ (((sb >> 9) & 1) << 5); R = (st >> 1) * 16 + swz / 64; C = (st & 1) * 32 + (swz % 64) / 2; }
__host__ __device__ __forceinline__ int perm32(int rho) { const int n = rho >> 4, i = rho & 15; return 8 * (i >> 2) + 4 * n + (i & 3); }

struct Unit { int pm, pn, ord; };
struct Gemm { const bf16_t* A; const bf16_t* Bt; int M, N, K; };

struct StaticOrder {
    int nM, nN, nwg, G, c;
    __host__ __device__ void init(int M, int N, int G_, int c_) { nM = M / BM; nN = N / BM; nwg = nM * nN; G = G_; c = c_; }
    __host__ __device__ bool next(int i, Unit& u) const {
        const long L = (long)i * G + c; if (L >= nwg) return false;
        int wgid = (int)L; { const int q = nwg / NXCD, r = nwg % NXCD, xcd = wgid % NXCD, off = wgid / NXCD; wgid = (xcd < r ? xcd * (q + 1) : r * (q + 1) + (xcd - r) * q) + off; }
        const int nig = WGM * nN, gid = wgid / nig, fm = gid * WGM, gsz = (nM - fm) < WGM ? (nM - fm) : WGM;
        u.pm = fm + ((wgid % nig) % gsz); u.pn = (wgid % nig) / gsz; u.ord = i; return true;
    }
    __device__ __forceinline__ void a_ready(const Unit&) const {}
    __device__ __forceinline__ void done(const Unit&) const {}
    __device__ __forceinline__ void after_first_stage() const {}
};

constexpr int MROWS = 16384;
#ifndef USE_F16
#define USE_F16 0
#endif
typedef _Float16 h16x2 __attribute__((ext_vector_type(2))); typedef _Float16 h16x8 __attribute__((ext_vector_type(8))); typedef float f32x2c __attribute__((ext_vector_type(2)));
#if USE_F16
__device__ __forceinline__ unsigned cvt_pk_bf16(float lo, float hi) { const f32x2c v = {lo, hi}; return __builtin_bit_cast(unsigned, __builtin_convertvector(v, h16x2)); }
#define PG8_MFMA16(a, b, c) __builtin_amdgcn_mfma_f32_16x16x32_f16(__builtin_bit_cast(pg8::h16x8, (a)), __builtin_bit_cast(pg8::h16x8, (b)), (c), 0, 0, 0)
#else
typedef __bf16 bf16x2c __attribute__((ext_vector_type(2)));
__device__ __forceinline__ unsigned cvt_pk_bf16(float lo, float hi) { const f32x2c v = {lo, hi}; return __builtin_bit_cast(unsigned, __builtin_convertvector(v, bf16x2c)); }
#define PG8_MFMA16(a, b, c) __builtin_amdgcn_mfma_f32_16x16x32_bf16((a), (b), (c), 0, 0, 0)
#endif
__device__ __forceinline__ u32x4 pack8(const f32x4 v0, const f32x4 v1) { u32x4 w; w.x = cvt_pk_bf16(v0[0], v0[1]); w.y = cvt_pk_bf16(v0[2], v0[3]); w.z = cvt_pk_bf16(v1[0], v1[1]); w.w = cvt_pk_bf16(v1[2], v1[3]); return w; }
__device__ __forceinline__ float row_rstd(const float* ssq, int row) {
    const float s = (ssq[row] + ssq[MROWS + row]) + (ssq[2 * MROWS + row] + ssq[3 * MROWS + row]);
    return __builtin_amdgcn_rsqf(s * (1.0f / 1024.0f) + 1e-6f);
}
#define XPOSE_SETUP(stg_, wr_, wc_, fr_, fq_) const int xp_lane = (fq_) * 16 + (fr_), xp_tr = xp_lane >> 2, xp_tc = xp_lane & 3; PG8_LAS unsigned char* const xp_sl = (stg_) + ((wr_) * 4 + (wc_)) * 2048; \
    const int xp_wo = (fr_) * 64 + (((fq_) ^ ((fr_) >> 2)) << 4), xp_ro = xp_tr * 64 + ((xp_tc ^ (xp_tr >> 2)) << 4)
__device__ __forceinline__ u32x4 xpose_turn(PG8_LAS unsigned char* slot, int wo, int ro, const u32x4 v) { *(PG8_LAS u32x4*)(slot + wo) = v; return *(const PG8_LAS u32x4*)(slot + ro); }
#define XPOSE_TURN(slot_, v_) xpose_turn(xp_sl + (slot_) * 1024, xp_wo, xp_ro, (v_))
struct EpiQKV {
    static constexpr bool PERM = true, AFTER_DRAIN = false;
    bf16_t* O; const PG8_LAS float* rs; float c2; PG8_LAS unsigned char* stg;
    __device__ __forceinline__ void operator()(const f32x4 (&acc)[2][2][4][2], const Unit& u, int wr, int wc, int fr, int fq) const {
        XPOSE_SETUP(stg, wr, wc, fr, fq);
        const int row0 = u.pm * BM + wr * 64 + xp_tr, col0 = u.pn * BM + wc * 32 + 8 * xp_tc;
        const float sc = (u.pn < 4) ? c2 : 1.0f;
#pragma unroll
        for (int ai = 0; ai < 2; ++ai)
#pragma unroll
            for (int m = 0; m < 4; ++m) { const int row = row0 + ai * HALF + m * 16; const float rs = this->rs[u.ord * BM + ai * HALF + wr * 64 + m * 16 + fr] * sc; bf16_t* rowp = O + (size_t)row * 3072 + col0;
#pragma unroll
                for (int bj = 0; bj < 2; ++bj) *(u32x4*)(rowp + bj * HALF) = XPOSE_TURN(bj, pack8(acc[ai][bj][m][0] * rs, acc[ai][bj][m][1] * rs)); }
    }
};
struct EpiConvIn {
    static constexpr bool PERM = true, AFTER_DRAIN = false;
    bf16_t* Bo; bf16_t* CU; const PG8_LAS float* rs; PG8_LAS unsigned char* stg;
    __device__ __forceinline__ void operator()(const f32x4 (&acc)[2][2][4][2], const Unit& u, int wr, int wc, int fr, int fq) const {
        XPOSE_SETUP(stg, wr, wc, fr, fq);
        const int row0 = u.pm * BM + wr * 64 + xp_tr;
        if (u.pn < 4) {
            const int col0 = u.pn * BM + wc * 32 + 8 * xp_tc;
#pragma unroll
            for (int ai = 0; ai < 2; ++ai)
#pragma unroll
                for (int m = 0; m < 4; ++m) { const int row = row0 + ai * HALF + m * 16; const float rs = this->rs[u.ord * BM + ai * HALF + wr * 64 + m * 16 + fr]; bf16_t* rowp = Bo + (size_t)row * 1024 + col0;
#pragma unroll
                    for (int bj = 0; bj < 2; ++bj) *(u32x4*)(rowp + bj * HALF) = XPOSE_TURN(bj, pack8(acc[ai][bj][m][0] * rs, acc[ai][bj][m][1] * rs)); }
        } else {
            const int col0 = (u.pn - 4) * HALF + wc * 32 + 8 * xp_tc;
#pragma unroll
            for (int ai = 0; ai < 2; ++ai)
#pragma unroll
                for (int m = 0; m < 4; ++m) { const int row = row0 + ai * HALF + m * 16; const float rs = this->rs[u.ord * BM + ai * HALF + wr * 64 + m * 16 + fr]; const float rs2 = rs * rs;
                    *(u32x4*)(CU + (size_t)row * 1024 + col0) = XPOSE_TURN(m & 1, pack8(acc[ai][0][m][0] * acc[ai][1][m][0] * rs2, acc[ai][0][m][1] * acc[ai][1][m][1] * rs2)); }
        }
    }
};
__device__ __forceinline__ f32x4 swiglu4(const f32x4 g, const f32x4 u, float rs) {
    const f32x4 gk = g * (rs * -1.4426950408889634f);
    f32x4 t; t[0] = __builtin_amdgcn_exp2f(gk[0]); t[1] = __builtin_amdgcn_exp2f(gk[1]); t[2] = __builtin_amdgcn_exp2f(gk[2]); t[3] = __builtin_amdgcn_exp2f(gk[3]);
    const f32x4 d = t + 1.0f;
    f32x4 r; r[0] = __builtin_amdgcn_rcpf(d[0]); r[1] = __builtin_amdgcn_rcpf(d[1]); r[2] = __builtin_amdgcn_rcpf(d[2]); r[3] = __builtin_amdgcn_rcpf(d[3]);
    return (g * u) * (r * (rs * rs));
}
struct EpiSwiGLU {
    static constexpr bool PERM = true, AFTER_DRAIN = false;
    bf16_t* Hd; const PG8_LAS float* rs; PG8_LAS unsigned char* stg;
    __device__ __forceinline__ void operator()(const f32x4 (&acc)[2][2][4][2], const Unit& u, int wr, int wc, int fr, int fq) const {
        XPOSE_SETUP(stg, wr, wc, fr, fq);
        const int row0 = u.pm * BM + wr * 64 + xp_tr, col0 = u.pn * HALF + wc * 32 + 8 * xp_tc;
#pragma unroll
        for (int ai = 0; ai < 2; ++ai)
#pragma unroll
            for (int m = 0; m < 4; ++m) { const int row = row0 + ai * HALF + m * 16; const float rs = this->rs[u.ord * BM + ai * HALF + wr * 64 + m * 16 + fr];
                *(u32x4*)(Hd + (size_t)row * 2816 + col0) = XPOSE_TURN(m & 1, pack8(swiglu4(acc[ai][0][m][0], acc[ai][1][m][0], rs), swiglu4(acc[ai][0][m][1], acc[ai][1][m][1], rs))); }
    }
};
__device__ __forceinline__ void unpack8f(const u32x4 w, f32x4& a, f32x4& b) {
#if USE_F16
    const unsigned w0 = w.x, w1 = w.y, w2 = w.z, w3 = w.w;
    const f32x2c p0 = __builtin_convertvector(__builtin_bit_cast(h16x2, w0), f32x2c), p1 = __builtin_convertvector(__builtin_bit_cast(h16x2, w1), f32x2c);
    const f32x2c p2 = __builtin_convertvector(__builtin_bit_cast(h16x2, w2), f32x2c), p3 = __builtin_convertvector(__builtin_bit_cast(h16x2, w3), f32x2c);
    a[0] = p0.x; a[1] = p0.y; a[2] = p1.x; a[3] = p1.y; b[0] = p2.x; b[1] = p2.y; b[2] = p3.x; b[3] = p3.y;
#else
    a[0] = __builtin_bit_cast(float, w.x << 16); a[1] = __builtin_bit_cast(float, w.x & 0xffff0000u); a[2] = __builtin_bit_cast(float, w.y << 16); a[3] = __builtin_bit_cast(float, w.y & 0xffff0000u);
    b[0] = __builtin_bit_cast(float, w.z << 16); b[1] = __builtin_bit_cast(float, w.z & 0xffff0000u); b[2] = __builtin_bit_cast(float, w.w << 16); b[3] = __builtin_bit_cast(float, w.w & 0xffff0000u);
#endif
}
struct EpiRes {
    static constexpr bool PERM = true, AFTER_DRAIN = true;
    bf16_t* xb; float* ssq;
    __device__ __forceinline__ void fused(f32x4 (&acc)[2][2][4][2], const Unit& u, int wr, int wc, int fr, int fq, PG8_LAS unsigned char* lds, int wid, int lane) const {
        PG8_LAS float* P = (PG8_LAS float*)lds;
        const int col0 = u.pn * BM + wc * 32 + 8 * fq;
        u32x4 xr[2][4][2];
#pragma unroll
        for (int ai = 0; ai < 2; ++ai)
#pragma unroll
            for (int m = 0; m < 4; ++m) { const size_t off = (size_t)(u.pm * BM + ai * HALF + wr * 64 + m * 16 + fr) * 1024 + col0;
#pragma unroll
                for (int bj = 0; bj < 2; ++bj) xr[ai][m][bj] = *(const u32x4*)(xb + off + bj * HALF); }
#pragma unroll
        for (int ai = 0; ai < 2; ++ai)
#pragma unroll
            for (int m = 0; m < 4; ++m) { const int rl = ai * HALF + wr * 64 + m * 16 + fr; const size_t off = (size_t)(u.pm * BM + rl) * 1024 + col0; float s = 0.f;
#pragma unroll
                for (int bj = 0; bj < 2; ++bj) { f32x4 x0, x1; unpack8f(xr[ai][m][bj], x0, x1);
                    const f32x4 v0 = acc[ai][bj][m][0] + x0, v1 = acc[ai][bj][m][1] + x1;
                    *(u32x4*)(xb + off + bj * HALF) = pack8(v0, v1);
                    s += (v0[0] * v0[0] + v0[1] * v0[1]) + (v0[2] * v0[2] + v0[3] * v0[3]) + (v1[0] * v1[0] + v1[1] * v1[1]) + (v1[2] * v1[2] + v1[3] * v1[3]); }
                s += __shfl_xor(s, 16); s += __shfl_xor(s, 32);
                if (fq == 0) P[rl * 4 + wc] = s; }
        asm volatile("s_waitcnt lgkmcnt(0)" ::: "memory"); __builtin_amdgcn_s_barrier(); asm volatile("" ::: "memory");
        const int t = wid * 64 + lane;
        if (t < 256) { const f32x4 p = *(const PG8_LAS f32x4*)(P + t * 4); ssq[(size_t)u.pn * MROWS + u.pm * BM + t] = (p[0] + p[1]) + (p[2] + p[3]); }
    }
};

template <class Epi, class Sched, bool ALIGN_EPI = false, bool SP2 = false>
__device__ __forceinline__ void gemm_phase(PG8_LAS unsigned char* lds, const Gemm g, const Sched& S, const Epi& E) {
    const int tid = threadIdx.x, wid = __builtin_amdgcn_readfirstlane(tid >> 6), lane = tid & 63, wr = wid >> 2, wc = wid & 3, fr = lane & 15, fq = lane >> 4;
    const int K = g.K, nt = K / BK;
    unsigned voffA[2], voffB[2];
#pragma unroll
    for (int i = 0; i < 2; ++i) { int R, C; stage_rc(tid * 16 + i * 8192, R, C); const int Rb = Epi::PERM ? ((R & ~31) + perm32(R & 31)) : R;
        voffA[i] = (unsigned)(R * K + C) * 2u; voffB[i] = (unsigned)(Rb * K + C) * 2u; }
    const size_t kstep = (size_t)(BK * 2);
    const size_t hstep = (size_t)HALF * K * 2;
    const size_t tstep = 2 * hstep;
    const unsigned ldsw = (unsigned)wid * 1024u;
    const int aoff = lds_byte(wr * 64 + fr, fq * 8), boff = lds_byte(wc * 32 + fr, fq * 8);
#define PG8_SA(b, h) (((b) * 2 + (h)) * HTB)
#define PG8_SB(b, h) ((4 + (b) * 2 + (h)) * HTB)
#define PG8_STAGE(bufoff, gbase, voff) do { _Pragma("unroll") for (int _i = 0; _i < 2; ++_i) \
        __builtin_amdgcn_global_load_lds((const unsigned*)((const char*)(gbase) + (voff)[_i]), (PG8_LAS unsigned*)(lds + (bufoff) + ldsw + _i * 8192), 16, 0, 0); } while (0)
#define PG8_LDA(dst, b, h) do { _Pragma("unroll") for (int m = 0; m < 4; ++m) _Pragma("unroll") for (int k = 0; k < 2; ++k) dst[m][k] = *(const PG8_LAS bf16x8*)(lds + PG8_SA(b, h) + aoff + m * 2048 + k * 1024); } while (0)
#define PG8_LDB(dst, b, h) do { _Pragma("unroll") for (int n = 0; n < 2; ++n) _Pragma("unroll") for (int k = 0; k < 2; ++k) dst[n][k] = *(const PG8_LAS bf16x8*)(lds + PG8_SB(b, h) + boff + n * 2048 + k * 1024); } while (0)
#define PG8_MMA(ai, bj, At, Bt) do { __builtin_amdgcn_s_setprio(1); _Pragma("unroll") for (int m = 0; m < 4; ++m) _Pragma("unroll") for (int n = 0; n < 2; ++n) _Pragma("unroll") for (int k = 0; k < 2; ++k) \
        acc[ai][bj][m][n] = PG8_MFMA16(Bt[n][k], At[m][k], acc[ai][bj][m][n]); __builtin_amdgcn_s_setprio(0); } while (0)
#define PG8_WAIT_V(n) asm volatile("s_waitcnt vmcnt(" #n ")" ::: "memory")
#define PG8_WAIT_L(n) asm volatile("s_waitcnt lgkmcnt(" #n ")" ::: "memory")
#define PG8_BAR __builtin_amdgcn_s_barrier()
#define PG8_SCHED __builtin_amdgcn_sched_barrier(0)
    Unit cur, nxt; int ui = 0;
    if (!S.next(0, cur)) return;
    f32x4 acc[2][2][4][2];
#pragma unroll
    for (int a = 0; a < 2; ++a)
#pragma unroll
        for (int b = 0; b < 2; ++b)
#pragma unroll
            for (int m = 0; m < 4; ++m)
#pragma unroll
                for (int n = 0; n < 2; ++n) acc[a][b][m][n] = (f32x4){0.f, 0.f, 0.f, 0.f};
    bf16x8 At[4][2], B0[2][2], B1[2][2];
    const char* cA = (const char*)g.A + (size_t)cur.pm * tstep; const char* cB = (const char*)g.Bt + (size_t)cur.pn * tstep;
    S.a_ready(cur);
    if constexpr (SP2) {
        PG8_STAGE(PG8_SB(0, 0), cB, voffB); PG8_STAGE(PG8_SB(0, 1), cB + hstep, voffB); PG8_STAGE(PG8_SA(0, 0), cA, voffA); PG8_STAGE(PG8_SA(0, 1), cA + hstep, voffA);
        S.after_first_stage();
        if (wr == 1) PG8_BAR;
        PG8_WAIT_V(2); PG8_BAR;
        PG8_STAGE(PG8_SB(1, 0), cB + kstep, voffB); PG8_STAGE(PG8_SA(1, 0), cA + kstep, voffA); PG8_STAGE(PG8_SB(1, 1), cB + hstep + kstep, voffB);
        PG8_WAIT_V(6); PG8_BAR;
    } else {
        PG8_STAGE(PG8_SB(0, 0), cB, voffB); PG8_STAGE(PG8_SA(0, 0), cA, voffA); PG8_STAGE(PG8_SB(0, 1), cB + hstep, voffB); PG8_STAGE(PG8_SA(0, 1), cA + hstep, voffA);
        if (wr == 1) PG8_BAR;
        PG8_WAIT_V(4); PG8_BAR;
        PG8_STAGE(PG8_SB(1, 0), cB + kstep, voffB); PG8_STAGE(PG8_SA(1, 0), cA + kstep, voffA); PG8_STAGE(PG8_SB(1, 1), cB + hstep + kstep, voffB);
        PG8_WAIT_V(6); PG8_BAR;
    }
    for (;;) {
        const bool has_next = S.next(ui + 1, nxt);
        const char* nA = has_next ? (const char*)g.A + (size_t)nxt.pm * tstep : cA; const char* nB = has_next ? (const char*)g.Bt + (size_t)nxt.pn * tstep : cB;
        for (int t = 0; t < nt; t += 2) {
            const bool last = (t == nt - 2);
            const char* a1 = cA + (size_t)(t + 1) * kstep;
            const char* a2 = last ? nA : cA + (size_t)(t + 2) * kstep; const char* b2 = last ? nB : cB + (size_t)(t + 2) * kstep;
            const char* a3 = a2 + kstep; const char* b3 = b2 + kstep;
            if (last && has_next) S.a_ready(nxt);
            if constexpr (SP2) {
            PG8_LDB(B0, 0, 0); PG8_LDB(B1, 0, 1); PG8_SCHED; PG8_LDA(At, 0, 0); PG8_STAGE(PG8_SA(1, 1), a1 + hstep, voffA);
            PG8_WAIT_V(8); PG8_WAIT_L(0); PG8_BAR; PG8_MMA(0, 0, At, B0); PG8_MMA(0, 1, At, B1); PG8_BAR; PG8_SCHED;
            PG8_LDA(At, 0, 1); PG8_STAGE(PG8_SB(0, 0), b2, voffB); PG8_STAGE(PG8_SB(0, 1), b2 + hstep, voffB); PG8_STAGE(PG8_SA(0, 0), a2, voffA);
            PG8_WAIT_V(8); PG8_WAIT_L(0); PG8_BAR; PG8_MMA(1, 0, At, B0); PG8_MMA(1, 1, At, B1); PG8_BAR; PG8_SCHED;
            PG8_LDB(B0, 1, 0); PG8_LDB(B1, 1, 1); PG8_SCHED; PG8_LDA(At, 1, 0); PG8_STAGE(PG8_SA(0, 1), a2 + hstep, voffA);
            PG8_WAIT_V(8); PG8_WAIT_L(0); PG8_BAR; PG8_MMA(0, 0, At, B0); PG8_MMA(0, 1, At, B1); PG8_BAR; PG8_SCHED;
            PG8_LDA(At, 1, 1); PG8_STAGE(PG8_SB(1, 0), b3, voffB); PG8_STAGE(PG8_SB(1, 1), b3 + hstep, voffB); PG8_STAGE(PG8_SA(1, 0), a3, voffA);
            PG8_WAIT_V(8); PG8_WAIT_L(0); PG8_BAR; PG8_MMA(1, 0, At, B0); PG8_MMA(1, 1, At, B1); PG8_BAR; PG8_SCHED;
            } else {
            PG8_LDB(B0, 0, 0); PG8_SCHED; PG8_LDA(At, 0, 0); PG8_STAGE(PG8_SA(1, 1), a1 + hstep, voffA);
            PG8_WAIT_L(8); PG8_BAR; PG8_WAIT_L(0); PG8_MMA(0, 0, At, B0); PG8_BAR; PG8_SCHED;
            PG8_LDB(B1, 0, 1); PG8_STAGE(PG8_SB(0, 0), b2, voffB);
            PG8_BAR; PG8_WAIT_L(0); PG8_MMA(0, 1, At, B1); PG8_BAR;
            PG8_LDA(At, 0, 1); PG8_STAGE(PG8_SA(0, 0), a2, voffA);
            PG8_BAR; PG8_WAIT_L(0); PG8_MMA(1, 0, At, B0); PG8_BAR; PG8_SCHED;
            PG8_STAGE(PG8_SB(0, 1), b2 + hstep, voffB);
            PG8_WAIT_V(6); PG8_BAR; PG8_MMA(1, 1, At, B1); PG8_BAR;
            PG8_LDB(B0, 1, 0); PG8_SCHED; PG8_LDA(At, 1, 0); PG8_STAGE(PG8_SA(0, 1), a2 + hstep, voffA);
            PG8_WAIT_L(8); PG8_BAR; PG8_WAIT_L(0); PG8_MMA(0, 0, At, B0); PG8_BAR; PG8_SCHED;
            PG8_LDB(B1, 1, 1); PG8_STAGE(PG8_SB(1, 0), b3, voffB);
            PG8_BAR; PG8_WAIT_L(0); PG8_MMA(0, 1, At, B1); PG8_BAR;
            PG8_LDA(At, 1, 1); PG8_STAGE(PG8_SA(1, 0), a3, voffA);
            PG8_BAR; PG8_WAIT_L(0); PG8_MMA(1, 0, At, B0); PG8_BAR; PG8_SCHED;
            PG8_STAGE(PG8_SB(1, 1), b3 + hstep, voffB);
            PG8_WAIT_V(6); PG8_BAR; PG8_MMA(1, 1, At, B1); PG8_BAR;
            }
        }
        if constexpr (ALIGN_EPI) { if (wr == 0) PG8_BAR; }
        if constexpr (!Epi::AFTER_DRAIN) { E(acc, cur, wr, wc, fr, fq);
#if defined(DUP_EPI)
            asm volatile("" ::: "memory"); E(acc, cur, wr, wc, fr, fq);
#endif
            S.done(cur); }
        if (!has_next) break;
#pragma unroll
        for (int a = 0; a < 2; ++a)
#pragma unroll
            for (int b = 0; b < 2; ++b)
#pragma unroll
                for (int m = 0; m < 4; ++m)
#pragma unroll
                    for (int n = 0; n < 2; ++n) acc[a][b][m][n] = (f32x4){0.f, 0.f, 0.f, 0.f};
        cur = nxt; cA = nA; cB = nB; ++ui;
        if constexpr (ALIGN_EPI) { if (wr == 1) PG8_BAR; }
    }
    PG8_WAIT_V(0);
    if constexpr (!ALIGN_EPI) { if (wr == 0) PG8_BAR; }
    PG8_BAR;
    if constexpr (Epi::AFTER_DRAIN) { E.fused(acc, cur, wr, wc, fr, fq, lds, wid, lane); S.done(cur); }
#undef PG8_SA
#undef PG8_SB
#undef PG8_STAGE
#undef PG8_LDA
#undef PG8_LDB
#undef PG8_MMA
#undef PG8_WAIT_V
#undef PG8_WAIT_L
#undef PG8_BAR
#undef PG8_SCHED
}
}

constexpr int NWAVES = 8;
constexpr int BATCH = 8, SEQ = 2048, D = 1024, DEPTH = 4, NH = 16, HD = 64, FF = 2816, NB = 32;
constexpr int M = BATCH * SEQ;
constexpr float C2 = 0.125f * 1.4426950408889634f;
constexpr float LOG2E = 1.4426950408889634f;

constexpr size_t MiB = 1u << 20;
constexpr size_t WS_CTL = 0, CTL_ZERO_BYTES = 64 * 1024;
constexpr size_t WS_SSQ = 1 * MiB;
constexpr size_t WS_W = 2 * MiB;
constexpr size_t W_IN_OFF = 0, W_OUT_OFF = (size_t)3072 * 1024 * 2, W_GU_OFF = W_OUT_OFF + (size_t)1024 * 1024 * 2, W_DN_OFF = W_GU_OFF + (size_t)5632 * 1024 * 2;
constexpr size_t W_LAYER = W_DN_OFF + (size_t)1024 * 2816 * 2;
constexpr size_t WS_XB = 100 * MiB;
constexpr size_t WS_ACT = 132 * MiB;
constexpr size_t WS_MIX = 228 * MiB;
constexpr size_t WS_END = 260 * MiB;
static_assert(WS_W + 4 * W_LAYER <= WS_XB && WS_MIX + (size_t)M * D * 2 <= WS_END, "d_ws map");
constexpr int CW_TMO = 0;
constexpr int CW_BAR = 1024;

constexpr int RING_OFF = 0, RING_BYTES = 131072;
constexpr int LDS_BYTES = 163840;
constexpr int LDSCTL_OFF = LDS_BYTES - 1024, MISC_OFF = LDSCTL_OFF + 320;

#define GAS __attribute__((address_space(1)))
#define LAS __attribute__((address_space(3)))
typedef unsigned short bf16;
typedef unsigned v4u __attribute__((ext_vector_type(4)));
typedef float f32x4 __attribute__((ext_vector_type(4)));
typedef GAS unsigned gu32;
#define RLX_AGENT __ATOMIC_RELAXED, __HIP_MEMORY_SCOPE_AGENT
#define LDS_WAIT() asm volatile("s_waitcnt lgkmcnt(0)" ::: "memory")
#define VM_WAIT() asm volatile("s_waitcnt vmcnt(0)" ::: "memory")
#if USE_F16
__device__ __forceinline__ unsigned f2bf(float f) { return (unsigned)__builtin_bit_cast(unsigned short, (_Float16)f); }
__device__ __forceinline__ unsigned pk2(float lo, float hi) { return pg8::cvt_pk_bf16(lo, hi); }
__device__ __forceinline__ float bf2f(unsigned short b) { return (float)__builtin_bit_cast(_Float16, b); }
#else
__device__ __forceinline__ unsigned f2bf(float f) { unsigned u = __builtin_bit_cast(unsigned, f); return (u + 0x7fffu + ((u >> 16) & 1u)) >> 16; }
__device__ __forceinline__ unsigned pk2(float lo, float hi) { return pg8::cvt_pk_bf16(lo, hi); }
__device__ __forceinline__ float bf2f(unsigned short b) { return __builtin_bit_cast(float, (unsigned)b << 16); }
#endif

#define XB_TMO      128
#define XB_XCNT(j)  (256  + 64 * (j))
#define XB_XSUB(j)  (1280 + 64 * (j))
#define XB_XGEN(j)  (2304 + 64 * (j))
#define XB_TOP      3328
#define XB_TOPGEN   3392
#define XCD_BAR_WORDS 3456
#define XB_SPIN_CAP (1u << 18)
__device__ __forceinline__ unsigned xb_ld(unsigned* p)              { return __hip_atomic_load(p, __ATOMIC_RELAXED, __HIP_MEMORY_SCOPE_AGENT); }
__device__ __forceinline__ unsigned xb_add(unsigned* p, unsigned v) { return __hip_atomic_fetch_add(p, v, __ATOMIC_RELAXED, __HIP_MEMORY_SCOPE_AGENT); }
__device__ __forceinline__ unsigned xb_xcc_id() { return (unsigned)__builtin_amdgcn_s_getreg((3 << 11) | 20) & 0xFu; }
#define XB_SPIN(cond, bar) do { unsigned _sp = 0; while (cond) { __builtin_amdgcn_s_sleep(1); \
    if ((++_sp & 255u) == 0u) { if (xb_ld(&(bar)[XB_TMO])) break; if (_sp > XB_SPIN_CAP) { atomicAdd(&(bar)[XB_TMO], 1u); break; } } } } while (0)
struct XcdBarrier { unsigned* bar; unsigned x; volatile LAS unsigned* st; };
#define XB_LOC(j)   (3520 + 64 * (j))
__device__ __forceinline__ XcdBarrier xcd_barrier_post(unsigned* bar, volatile LAS unsigned* st) {
    XcdBarrier b; b.bar = bar; b.x = xb_xcc_id(); b.st = st;
    if (threadIdx.x == 0) st[2] = xb_add(&bar[XB_XCNT(b.x)], 1u);
    return b;
}
__device__ __forceinline__ void xcc_local_barrier(const XcdBarrier& b, unsigned& seq) {
    asm volatile("s_waitcnt vmcnt(0)" ::: "memory");
    __syncthreads();
    if (threadIdx.x == 0) {
        unsigned* bar = b.bar;
        __builtin_amdgcn_s_waitcnt(0);
        __builtin_amdgcn_fence(__ATOMIC_ACQUIRE, "agent");
        xb_add(&bar[XB_LOC(b.x)], 1u);
        const unsigned target = 32u * (seq + 1u);
        XB_SPIN(xb_ld(&bar[XB_LOC(b.x)]) < target, bar);
        asm volatile("s_waitcnt vmcnt(0)" ::: "memory");
    }
    __syncthreads();
    ++seq;
}
__device__ __forceinline__ void xcd_barrier_complete(unsigned* bar, unsigned x, unsigned& nloc, unsigned& nx) {
    const unsigned G = gridDim.x * gridDim.y * gridDim.z;
    unsigned sum, cnt, mine, sp = 0u;
    for (;;) {
        sum = 0u; cnt = 0u; mine = 0u;
#pragma unroll
        for (unsigned j = 0; j < 16; ++j) { const unsigned c = xb_ld(&bar[XB_XCNT(j)]); sum += c; cnt += (c > 0u) ? 1u : 0u; mine = (j == x) ? c : mine; }
        if (sum == G) break;
        __builtin_amdgcn_s_sleep(1);
        if ((++sp & 255u) == 0u) { if (xb_ld(&bar[XB_TMO])) break; if (sp > XB_SPIN_CAP) { atomicAdd(&bar[XB_TMO], 1u); break; } }
    }
    nloc = mine > 0u ? mine : 1u; nx = cnt > 0u ? cnt : 1u;
}
__device__ __forceinline__ void xcd_barrier(const XcdBarrier& b) {
    asm volatile("s_waitcnt vmcnt(0)" ::: "memory");
    __syncthreads();
    if (threadIdx.x == 0) {
        unsigned* bar = b.bar;
        __builtin_amdgcn_s_waitcnt(0);
        unsigned nloc = b.st[0], nx = b.st[1];
        if (nloc == 0u) { xcd_barrier_complete(bar, b.x, nloc, nx); b.st[0] = nloc; b.st[1] = nx; }
        const unsigned old = xb_add(&bar[XB_XSUB(b.x)], 1u);
        const unsigned gen = old / nloc;
        if (old + 1u == (gen + 1u) * nloc) {
            __builtin_amdgcn_fence(__ATOMIC_RELEASE, "agent");
            asm volatile("s_waitcnt vmcnt(0)" ::: "memory");
            const unsigned og = xb_add(&bar[XB_TOP], 1u);
            const unsigned tg = og / nx;
            if (og + 1u == (tg + 1u) * nx) xb_add(&bar[XB_TOPGEN], 1u);
            else XB_SPIN(xb_ld(&bar[XB_TOPGEN]) == tg, bar);
            __builtin_amdgcn_fence(__ATOMIC_ACQUIRE, "agent");
            xb_add(&bar[XB_XGEN(b.x)], 1u);
            asm volatile("s_waitcnt vmcnt(0)" ::: "memory");
        } else {
            XB_SPIN(xb_ld(&bar[XB_XGEN(b.x)]) == gen, bar);
            __builtin_amdgcn_fence(__ATOMIC_ACQUIRE, "agent");
            asm volatile("s_waitcnt vmcnt(0)" ::: "memory");
        }
    }
    __syncthreads();
}

struct Frame {
    LAS unsigned char* lds;
    volatile LAS unsigned* MISC;
    gu32* ctl;
    int tid, lane, wave, vcu, G;
};
__device__ __forceinline__ float wave_sum(float v) {
#pragma unroll
    for (int o = 1; o < 64; o <<= 1) v += __shfl_xor(v, o);
    return v;
}
__device__ __forceinline__ float wave_max(float v) {
#pragma unroll
    for (int o = 1; o < 64; o <<= 1) v = fmaxf(v, __shfl_xor(v, o));
    return v;
}

__device__ __forceinline__ void p0_transpose_item(const float* W, int K, int N, bf16* WT, int orow0, const float* gain, LAS unsigned char* T, int k0, int n0, int lane) {
    const int kq = lane >> 4, nl = (lane & 15) * 4;
    const GAS f32x4* src = (const GAS f32x4*)(W + (size_t)(k0 + 16 * kq) * N + n0 + nl);
    f32x4 v[16];
#pragma unroll
    for (int i = 0; i < 16; ++i) v[i] = __builtin_nontemporal_load(&src[(size_t)i * (N / 4)]);
    if (gain) {
        const GAS f32x4* gp = (const GAS f32x4*)(gain + k0 + 16 * kq);
#pragma unroll
        for (int q = 0; q < 4; ++q) { const f32x4 gq = gp[q];
#pragma unroll
            for (int e = 0; e < 4; ++e) v[4 * q + e] = v[4 * q + e] * gq[e]; }
    }
#pragma unroll
    for (int j = 0; j < 4; ++j) {
        const int n = nl + j, sw = (n >> 2) & 7;
        v4u a, b;
        a.x = pk2(v[0][j], v[1][j]); a.y = pk2(v[2][j], v[3][j]); a.z = pk2(v[4][j], v[5][j]); a.w = pk2(v[6][j], v[7][j]);
        b.x = pk2(v[8][j], v[9][j]); b.y = pk2(v[10][j], v[11][j]); b.z = pk2(v[12][j], v[13][j]); b.w = pk2(v[14][j], v[15][j]);
        *(LAS v4u*)(T + n * 128 + (((2 * kq) ^ sw) << 4)) = a;
        *(LAS v4u*)(T + n * 128 + (((2 * kq + 1) ^ sw) << 4)) = b;
    }
    LDS_WAIT(); asm volatile("" ::: "memory");
#pragma unroll
    for (int i = 0; i < 8; ++i) { const int n = 8 * i + (lane >> 3), c = lane & 7;
        const v4u o = *(const LAS v4u*)(T + n * 128 + ((c ^ ((n >> 2) & 7)) << 4));
        *(GAS v4u*)(WT + (size_t)(orow0 + n) * K + k0 + 8 * c) = o; }
    LDS_WAIT(); asm volatile("" ::: "memory");
}
struct Ptrs {
    const float *x, *mix_norm, *ffn_norm, *final_norm, *conv_w_in, *conv_kernel, *conv_w_out, *attn_w_qkv, *attn_w_out, *rel_bias, *w_gate, *w_up, *w_down;
    float* out; unsigned char* ws;
};
__device__ __forceinline__ void convert_layer_weights(Frame& F, const Ptrs& P, int li, int gw, int NGW, int part  ) {
    LAS unsigned char* scr = F.lds + RING_OFF + F.wave * 8192;
    constexpr int I_IN = 16 * 48, I_OUT = 16 * 16, I_G = 16 * 44, I_DN = 44 * 16, I_LAYER = I_IN + I_OUT + 2 * I_G + I_DN;
    const int j = li >> 1;
    bf16* wl = (bf16*)(P.ws + WS_W + (size_t)li * W_LAYER);
    const int it_lo = (part == 2) ? I_LAYER / 2 : 0, it_hi = (part == 1) ? I_LAYER / 2 : I_LAYER;
    for (int it = it_lo + gw; it < it_hi; it += NGW) {
        int r = it;
        if (r < I_IN) {
            const int kb = r / 48, nb = r % 48, n0 = nb * 64;
            if ((li & 1) == 0) {
                int orow; if (n0 < 1024) orow = n0; else if (n0 < 2048) { const int f = n0 - 1024; orow = 1024 + 256 * (f >> 7) + (f & 127); } else { const int f = n0 - 2048; orow = 1024 + 256 * (f >> 7) + 128 + (f & 127); }
                p0_transpose_item(P.conv_w_in + (size_t)j * 1024 * 3072, 1024, 3072, (bf16*)((char*)wl + W_IN_OFF), orow, P.mix_norm + li * 1024, scr, kb * 64, n0, F.lane);
            } else {
                p0_transpose_item(P.attn_w_qkv + (size_t)j * 1024 * 3072, 1024, 3072, (bf16*)((char*)wl + W_IN_OFF), n0, P.mix_norm + li * 1024, scr, kb * 64, n0, F.lane);
            }
            continue;
        }
        r -= I_IN;
        if (r < I_OUT) {
            const int kb = r / 16, nb = r % 16;
            const float* src = ((li & 1) == 0) ? P.conv_w_out + (size_t)j * 1024 * 1024 : P.attn_w_out + (size_t)j * 1024 * 1024;
            p0_transpose_item(src, 1024, 1024, (bf16*)((char*)wl + W_OUT_OFF), nb * 64, nullptr, scr, kb * 64, nb * 64, F.lane);
            continue;
        }
        r -= I_OUT;
        if (r < 2 * I_G) {
            const int up = r >= I_G; if (up) r -= I_G;
            const int kb = r / 44, nb = r % 44, n0 = nb * 64;
            const int orow = 256 * (n0 >> 7) + (up ? 128 : 0) + (n0 & 127);
            p0_transpose_item((up ? P.w_up : P.w_gate) + (size_t)li * 1024 * 2816, 1024, 2816, (bf16*)((char*)wl + W_GU_OFF), orow, P.ffn_norm + li * 1024, scr, kb * 64, n0, F.lane);
            continue;
        }
        r -= 2 * I_G;
        { const int kb = r / 16, nb = r % 16;
          p0_transpose_item(P.w_down + (size_t)li * 2816 * 1024, 2816, 1024, (bf16*)((char*)wl + W_DN_OFF), nb * 64, nullptr, scr, kb * 64, nb * 64, F.lane); }
    }
}
__device__ __forceinline__ void p0_prologue(Frame& F, const Ptrs& P) {
    const int gw = F.vcu * NWAVES + F.wave, NGW = F.G * NWAVES;
    bf16* xb = (bf16*)(P.ws + WS_XB); float* ssq = (float*)(P.ws + WS_SSQ);
    f32x4 xv[4][2][4];
#pragma unroll
    for (int tr = 0; tr < 4; ++tr) { const int m = 2 * gw + 2 * NGW * tr;
        if (m < M) {
#pragma unroll
            for (int rr = 0; rr < 2; ++rr) { const GAS f32x4* xr = (const GAS f32x4*)(P.x + (size_t)(m + rr) * D) + F.lane;
#pragma unroll
                for (int q = 0; q < 4; ++q) xv[tr][rr][q] = __builtin_nontemporal_load(&xr[64 * q]); } } }
    convert_layer_weights(F, P, 0, gw, NGW, 0);
#define P0_ROWS(v_, m_) do { float s[2] = {0.f, 0.f}; \
        _Pragma("unroll") for (int rr = 0; rr < 2; ++rr) { \
            _Pragma("unroll") for (int q = 0; q < 4; ++q) s[rr] += (v_[rr][q].x * v_[rr][q].x + v_[rr][q].y * v_[rr][q].y) + (v_[rr][q].z * v_[rr][q].z + v_[rr][q].w * v_[rr][q].w); \
            s[rr] = wave_sum(s[rr]); \
            GAS unsigned long long* o8 = (GAS unsigned long long*)(xb + (size_t)((m_) + rr) * D) + F.lane; \
            _Pragma("unroll") for (int q = 0; q < 4; ++q) o8[64 * q] = (unsigned long long)pk2(v_[rr][q].x, v_[rr][q].y) | ((unsigned long long)pk2(v_[rr][q].z, v_[rr][q].w) << 32); \
            if (F.lane < 4) ssq[(size_t)F.lane * M + (m_) + rr] = (F.lane == 0) ? s[rr] : 0.f; } } while (0)
#pragma unroll
    for (int tr = 0; tr < 4; ++tr) { const int m = 2 * gw + 2 * NGW * tr; if (m < M) P0_ROWS(xv[tr], m); }
    for (int m = 2 * gw + 8 * NGW; m < M; m += 2 * NGW) {
        f32x4 v[2][4];
#pragma unroll
        for (int rr = 0; rr < 2; ++rr) { const GAS f32x4* xr = (const GAS f32x4*)(P.x + (size_t)(m + rr) * D) + F.lane;
#pragma unroll
            for (int q = 0; q < 4; ++q) v[rr][q] = __builtin_nontemporal_load(&xr[64 * q]); }
        P0_ROWS(v, m);
    }
#undef P0_ROWS
}

__device__ __forceinline__ void unpack8(const v4u w, float (&f)[8]) {
    f32x4 a, b; pg8::unpack8f(w, a, b);
    f[0] = a[0]; f[1] = a[1]; f[2] = a[2]; f[3] = a[3]; f[4] = b[0]; f[5] = b[1]; f[6] = b[2]; f[7] = b[3];
}
__device__ __forceinline__ void conv_pass(Frame& F, const bf16* Bo, const bf16* CU, const float* ck, bf16* G) {
    const int nthr = F.G * NWAVES * 64;
    for (int item = F.vcu * (NWAVES * 64) + F.tid; item < (M / 16) * 128; item += nthr) {
        const int cg = item & 127, rb = item >> 7, t0 = rb * 16, c0 = cg * 8;
        float k0[8], k1[8], k2[8];
#pragma unroll
        for (int i = 0; i < 8; ++i) { k0[i] = ck[c0 + i]; k1[i] = ck[1024 + c0 + i]; k2[i] = ck[2048 + c0 + i]; }
        float p2[8], p1[8];
        if ((t0 & (SEQ - 1)) == 0) {
#pragma unroll
            for (int i = 0; i < 8; ++i) { p2[i] = 0.f; p1[i] = 0.f; }
        } else {
            unpack8(*(const GAS v4u*)(CU + (size_t)(t0 - 2) * 1024 + c0), p2); unpack8(*(const GAS v4u*)(CU + (size_t)(t0 - 1) * 1024 + c0), p1);
        }
        v4u cw[16], bw[16];
#pragma unroll
        for (int r = 0; r < 16; ++r) { cw[r] = *(const GAS v4u*)(CU + (size_t)(t0 + r) * 1024 + c0); bw[r] = *(const GAS v4u*)(Bo + (size_t)(t0 + r) * 1024 + c0); }
#pragma unroll
        for (int r = 0; r < 16; ++r) {
            float cur[8], bb[8]; unpack8(cw[r], cur); unpack8(bw[r], bb);
            float g[8];
#pragma unroll
            for (int i = 0; i < 8; ++i) { g[i] = bb[i] * (k0[i] * p2[i] + k1[i] * p1[i] + k2[i] * cur[i]); p2[i] = p1[i]; p1[i] = cur[i]; }
            v4u o; o.x = pk2(g[0], g[1]); o.y = pk2(g[2], g[3]); o.z = pk2(g[4], g[5]); o.w = pk2(g[6], g[7]);
            *(GAS v4u*)(G + (size_t)(t0 + r) * 1024 + c0) = o;
        }
    }
}

__device__ __forceinline__ int t5_bucket(int d) {
    if (d < 16) return d;
    int b = 16;
    b += (d >= 22); b += (d >= 30); b += (d >= 40); b += (d >= 54); b += (d >= 73); b += (d >= 99); b += (d >= 134); b += (d >= 182);
    b += (d >= 246); b += (d >= 332); b += (d >= 450); b += (d >= 609); b += (d >= 825); b += (d >= 1117); b += (d >= 1513);
    return b;
}
__device__ __forceinline__ void attn_simple(Frame& F, const bf16* QKV, const float* rel_bias, bf16* O) {
    LAS float* qs = (LAS float*)(F.lds + RING_OFF + F.wave * 4096);
    LAS float* ps = qs + 64;
    const int gw = F.vcu * NWAVES + F.wave, NGW = F.G * NWAVES, lane = F.lane;
    for (int pair = gw; pair < M * NH; pair += NGW) {
        const int tok = pair >> 4, h = pair & 15, t = tok & (SEQ - 1), rowbase = tok - t;
        qs[lane] = bf2f(QKV[(size_t)tok * 3072 + h * 64 + lane]);
        LDS_WAIT(); asm volatile("" ::: "memory");
        float sv[7]; float mx = -1e30f;
#pragma unroll
        for (int rnd = 0; rnd < 7; ++rnd) {
            const int e = rnd * 64 + lane; const int g = e / 129, j = e - g * 129; const int dil = (g == 0) ? 1 : (g == 1) ? 4 : 16; const int tk = t - j * dil;
            float s = -1e30f;
            if (e < 387 && tk >= 0) {
                const GAS v4u* kr = (const GAS v4u*)(QKV + (size_t)(rowbase + tk) * 3072 + 1024 + h * 64);
                float dot = 0.f;
#pragma unroll
                for (int c = 0; c < 8; ++c) { float kf[8]; unpack8(kr[c], kf);
#pragma unroll
                    for (int i = 0; i < 8; ++i) dot += qs[c * 8 + i] * kf[i]; }
                s = dot + rel_bias[t5_bucket(j * dil) * NH + h] * LOG2E;
            }
            sv[rnd] = s; mx = fmaxf(mx, s);
        }
        mx = wave_max(mx);
        float sum = 0.f;
#pragma unroll
        for (int rnd = 0; rnd < 7; ++rnd) { const float p = __builtin_amdgcn_exp2f(sv[rnd] - mx); sum += p; ps[rnd * 64 + lane] = p; }
        sum = wave_sum(sum);
        LDS_WAIT(); asm volatile("" ::: "memory");
        float acc = 0.f;
        for (int g = 0; g < 3; ++g) { const int dil = (g == 0) ? 1 : (g == 1) ? 4 : 16;
            for (int j = 0; j < 129; ++j) { const int tk = t - j * dil; if (tk < 0) break;
                acc += ps[g * 129 + j] * bf2f(QKV[(size_t)(rowbase + tk) * 3072 + 2048 + h * 64 + lane]); } }
        O[(size_t)tok * 1024 + h * 64 + lane] = (bf16)f2bf(acc / sum);
        LDS_WAIT(); asm volatile("" ::: "memory");
    }
}


#ifndef FORCE_SLOWSM
#define FORCE_SLOWSM 0
#endif
namespace att {
constexpr bool FASTSM = (USE_F16 == 0);
typedef short bf16x8 __attribute__((ext_vector_type(8)));
typedef short s16x4 __attribute__((ext_vector_type(4)));
typedef short v4i16_t __attribute__((ext_vector_type(4)));
typedef float f32x16 __attribute__((ext_vector_type(16)));
typedef float f32x2_t __attribute__((ext_vector_type(2))); typedef __bf16 bf16x2_t __attribute__((ext_vector_type(2)));
constexpr int KIMG_OFF = 0, VIMG_OFF = 49152, WL_OFF = 98304, WL_BYTES = 5120, TBL_OFF = WL_OFF + 8 * WL_BYTES;
constexpr int TBL_CP = 208, TBL_G = 4 * TBL_CP;
static_assert(TBL_OFF + 3 * TBL_G * 4 <= LDSCTL_OFF, "attention LDS map");
__device__ __forceinline__ int crow(int r, int hi) { return (r & 3) + 8 * (r >> 2) + 4 * hi; }
__device__ __forceinline__ unsigned cvtpk(float lo, float hi) { return pg8::cvt_pk_bf16(lo, hi); }
#if USE_F16
#define ATT_MFMA32(a, b, c) __builtin_amdgcn_mfma_f32_32x32x16_f16(__builtin_bit_cast(pg8::h16x8, (a)), __builtin_bit_cast(pg8::h16x8, (b)), (c), 0, 0, 0)
#else
#define ATT_MFMA32(a, b, c) __builtin_amdgcn_mfma_f32_32x32x16_bf16((a), (b), (c), 0, 0, 0)
#endif
__device__ __forceinline__ s16x4 vtr(const LAS unsigned char* p) { return __builtin_bit_cast(s16x4, __builtin_amdgcn_ds_read_tr16_b64_v4i16((LAS v4i16_t*)p)); }
__device__ __forceinline__ void build_tables(Frame& F, const float* rel_bias, int h) {
    LAS float* tbl = (LAS float*)(F.lds + TBL_OFF);
    for (int i = F.tid; i < 3 * TBL_G; i += NWAVES * 64) { const int g = i / TBL_G, e = i % TBL_G, s = e / TBL_CP, m = e % TBL_CP; const int n = m + s, rel = 159 - n;
        const int dil = (g == 0) ? 1 : (g == 1) ? 4 : 16;
        tbl[i] = (n < 192 && rel >= 0 && rel <= 128) ? rel_bias[t5_bucket(rel * dil) * NH + h] * LOG2E : -1e30f; }
}
template <int PH>
__device__ __forceinline__ void attn_phase(Frame& F, const bf16* QKV, const float* rel_bias, bf16* MIXp, bf16* O1p, float* LSE) {
    const int bh = F.vcu >> 1, c = F.vcu & 1, b = bh >> 4, h = bh & 15, w = F.wave, lane = F.lane;
    const int c31 = lane & 31, hi = lane >> 5;
    const size_t rowb = (size_t)b * SEQ;
    LAS unsigned char* Kimg = F.lds + KIMG_OFF; LAS unsigned char* Vimg = F.lds + VIMG_OFF;
    LAS unsigned char* wl = F.lds + WL_OFF + w * WL_BYTES;
    LAS float* wsf = (LAS float*)(wl + 4096);
    const LAS float* tblb = (const LAS float*)(F.lds + TBL_OFF);
    constexpr int NCH = (PH == 0) ? 8 : 4;
#define ATT_CHUNK(ci_, g_, resA_, resB_, c0_) do { if (PH == 0) { const int id_ = c + 2 * (ci_); \
            if (id_ < 8) { g_ = 0; resA_ = 0; c0_ = 256 * id_; } else { g_ = 1; resA_ = (id_ - 8) >> 1; c0_ = 256 * (((id_ - 8) & 1) ^ (((id_ - 8) >> 1) & 1)); } resB_ = resA_; } \
        else { const int id_ = c * 4 + (ci_); g_ = 2; resA_ = 2 * id_; resB_ = 2 * id_ + 1; c0_ = 0; } } while (0)
    const int lane_lr = (w < 4) ? 8 * w + (lane >> 3) : 16 * ((w - 4) & 1) + (lane >> 2);
    const int lane_co = (w < 4) ? 1024 + h * 64 + 8 * ((lane & 7) ^ ((4 * (w & 1) + (lane >> 4)) & 7)) : 2048 + h * 64 + 32 * ((w - 4) >> 1) + 8 * (lane & 3);
#define ATT_LOADCHUNK(ci_) do { int g_, ra_, rb_, c0_; ATT_CHUNK(ci_, g_, ra_, rb_, c0_); const int dil_ = (g_ == 0) ? 1 : (g_ == 1) ? 4 : 16; (void)rb_; \
        const size_t stride_ = (size_t)32 * dil_ * 3072; \
        if (PH == 0) { const bf16* base_ = QKV + ((long)rowb + (long)((c0_ - 128 + lane_lr) * dil_ + ra_)) * 3072 + lane_co; \
            if (c0_ != 0) { _Pragma("unroll") for (int i = 0; i < 4; ++i) pre[i] = *(const GAS v4u*)(base_ + i * stride_); } \
            _Pragma("unroll") for (int i = 4; i < 12; ++i) pre[i] = *(const GAS v4u*)(base_ + i * stride_); } \
        else { const bf16* base_ = QKV + (rowb + (size_t)(lane_lr * dil_ + ra_)) * 3072 + lane_co; \
            _Pragma("unroll") for (int i = 4; i < 8; ++i) { pre[i] = *(const GAS v4u*)(base_ + (i - 4) * stride_); pre[i + 4] = *(const GAS v4u*)(base_ + 3072 + (i - 4) * stride_); } } } while (0)
    v4u pre[12];
#define ATT_LOADQ(ci_) do { int g_, ra_, rb_, c0_; ATT_CHUNK(ci_, g_, ra_, rb_, c0_); const int dil_ = (g_ == 0) ? 1 : (g_ == 1) ? 4 : 16; \
        const int res_ = (PH == 1 && w >= 4) ? rb_ : ra_; const int m0_ = (PH == 1) ? 32 * ((w < 4) ? w : 7 - w) : c0_ + 32 * w; \
        const bf16* qp_ = QKV + (rowb + (size_t)((m0_ + c31) * dil_ + res_)) * 3072 + h * 64 + 8 * hi; \
        _Pragma("unroll") for (int s = 0; s < 4; ++s) qf[s] = *(const bf16x8*)(qp_ + 16 * s); } while (0)
    ATT_LOADCHUNK(0);
    if (PH == 0) build_tables(F, rel_bias, h);
    for (int ci = 0; ci < NCH; ++ci) {
        int g, resA, resB, c0; ATT_CHUNK(ci, g, resA, resB, c0);
        const int dil = (g == 0) ? 1 : (g == 1) ? 4 : 16;
        const int res = (PH == 1 && w >= 4) ? resB : resA;
        const int m0 = (PH == 1) ? 32 * ((w < 4) ? w : 7 - w) : c0 + 32 * w;
        const int tb0 = (PH == 1) ? ((w < 4) ? 0 : 4) + (m0 >> 5) : w;
        const int nskip = (m0 >= 128) ? 0 : 4 - (m0 >> 5);
        bf16x8 qf[4]; ATT_LOADQ(ci);
        __syncthreads();
        { LAS unsigned char* dst = ((w < 4) ? Kimg + w * 1024 : Vimg + (w - 4) * 1024) + lane * 16;
          if (PH == 0 && c0 != 0) {
#pragma unroll
            for (int i = 0; i < 4; ++i) *(LAS v4u*)(dst + i * 4096) = pre[i]; }
#pragma unroll
          for (int i = 4; i < 12; ++i) *(LAS v4u*)(dst + i * 4096) = pre[i]; }
        const int tq = (m0 + c31) * dil + res;
        float l0n = 0.f, l1n = 0.f;
        if (PH == 1) { l0n = LSE[(rowb + tq) * NH + h]; l1n = LSE[((size_t)M + rowb + tq) * NH + h]; }
        LDS_WAIT();
        __syncthreads();
        if (ci + 1 < NCH) ATT_LOADCHUNK(ci + 1);
        float mx = 0.f, ls = 0.f;
        f32x16 o[2];
        float zacc = 0.f; asm volatile("" : "+v"(zacc));
#pragma unroll
        for (int r = 0; r < 16; ++r) { o[0][r] = zacc; o[1][r] = zacc; }
        const int loff = ((lane >> 4) & 1) * 32 + (lane & 3) * 8 + (4 * hi + ((lane & 15) >> 2)) * 64;
        const int ta = 31 - c31 + 4 * hi, ts = ta & 3; const LAS f32x4* tb = (const LAS f32x4*)(tblb + g * TBL_G + ts * TBL_CP + (ta - ts));
        const LAS unsigned char* kbase = Kimg + tb0 * 4096 + c31 * 128; const LAS unsigned char* vbase = Vimg + tb0 * 4096;
#define ATT_QK(dst, kt_) do { const LAS f32x4* tq_ = tb + 8 * (kt_); _Pragma("unroll") for (int j = 0; j < 4; ++j) { const f32x4 t4 = tq_[2 * j]; dst[4 * j + 0] = t4[0]; dst[4 * j + 1] = t4[1]; dst[4 * j + 2] = t4[2]; dst[4 * j + 3] = t4[3]; } \
                const LAS unsigned char* kp_ = kbase + (kt_) * 4096; \
                _Pragma("unroll") for (int s = 0; s < 4; ++s) { const bf16x8 kf = *(const LAS bf16x8*)(kp_ + (((2 * s + hi) ^ ((c31 >> 1) & 7)) << 4)); dst = ATT_MFMA32(kf, qf[s], dst); } } while (0)
#define ATT_PV(a_, kt_) do { const LAS unsigned char* slot = vbase + (kt_) * 4096; \
                _Pragma("unroll") for (int ks = 0; ks < 2; ++ks) { \
                    v4u pw; pw.x = cvtpk(a_[8 * ks + 0], a_[8 * ks + 1]); pw.y = cvtpk(a_[8 * ks + 2], a_[8 * ks + 3]); pw.z = cvtpk(a_[8 * ks + 4], a_[8 * ks + 5]); pw.w = cvtpk(a_[8 * ks + 6], a_[8 * ks + 7]); \
                    const bf16x8 pa = __builtin_bit_cast(bf16x8, pw); \
                    osum = ATT_MFMA32(ones, pa, osum); \
                    _Pragma("unroll") for (int dh = 0; dh < 2; ++dh) { \
                        const s16x4 lo = vtr(slot + (dh * 2 + ks) * 1024 + loff), hh = vtr(slot + (dh * 2 + ks) * 1024 + loff + 512); \
                        const bf16x8 vb = (bf16x8){lo[0], lo[1], lo[2], lo[3], hh[0], hh[1], hh[2], hh[3]}; \
                        o[dh] = ATT_MFMA32(pa, vb, o[dh]); } } } while (0)
        f32x16 osum;
#pragma unroll
        for (int r = 0; r < 16; ++r) osum[r] = zacc;
        bf16x8 ones = (bf16x8){(short)0x3F80, (short)0x3F80, (short)0x3F80, (short)0x3F80, (short)0x3F80, (short)0x3F80, (short)0x3F80, (short)0x3F80};
        asm volatile("" : "+v"(ones));
        if (FASTSM) {
            int kt = 4; f32x16 an; ATT_QK(an, 4);
            for (;;) {
                f32x16 a = an;
                const int kn = (kt > nskip) ? kt - 1 : kt;
                ATT_QK(an, kn);
#pragma unroll
                for (int r = 0; r < 16; ++r) a[r] = __builtin_amdgcn_exp2f(a[r]);
                ATT_PV(a, kt);
                if (kt == nskip) break;
                --kt;
            }
            ls = osum[0];
        }
        { const float lt = ls;
          const bool redo = !FASTSM || FORCE_SLOWSM || !(lt > 1e-30f && lt < 1e30f);
          if (__builtin_expect(__any(redo), !FASTSM || FORCE_SLOWSM)) {
            mx = -1e30f;
            for (int kt = 4; kt >= nskip; --kt) { f32x16 a; ATT_QK(a, kt);
#pragma unroll
                for (int r = 0; r < 16; ++r) mx = fmaxf(mx, a[r]); }
            mx = fmaxf(mx, __shfl_xor(mx, 32));
            { float z = 0.f; asm volatile("" : "+v"(z));
#pragma unroll
              for (int r = 0; r < 16; ++r) { o[0][r] = z; o[1][r] = z; osum[r] = z; } }
            for (int kt = 4; kt >= nskip; --kt) { f32x16 a; ATT_QK(a, kt);
#pragma unroll
                for (int r = 0; r < 16; ++r) a[r] = __builtin_amdgcn_exp2f(a[r] - mx);
                ATT_PV(a, kt); }
            ls = osum[0];
          }
        }
#undef ATT_QK
#undef ATT_PV
        v4u m0w[4], o1w[4];
        if (PH == 1) {
#pragma unroll
            for (int i = 0; i < 4; ++i) { const int row = i * 8 + (lane >> 3), ch = lane & 7;
                const size_t off = (rowb + (size_t)((m0 + row) * dil + res)) * 1024 + h * 64 + ch * 8;
                m0w[i] = *(const GAS v4u*)(MIXp + off); o1w[i] = *(const GAS v4u*)(O1p + off); }
        }
        if (hi == 0) wsf[c31] = __builtin_amdgcn_rcpf(ls);
        float a0w = 0.f, a1w = 0.f, a2w = 0.f;
        if (PH == 1) {
            const float l2 = mx + __builtin_amdgcn_logf(ls), l0 = l0n, l1 = l1n;
            const float mm = fmaxf(l2, fmaxf(l0, l1)); const float w0 = __builtin_amdgcn_exp2f(l0 - mm), w1 = __builtin_amdgcn_exp2f(l1 - mm), w2 = __builtin_amdgcn_exp2f(l2 - mm);
            const float iw = __builtin_amdgcn_rcpf(w0 + w1 + w2);
            if (hi == 0) { wsf[32 + 3 * c31 + 0] = w0 * iw; wsf[32 + 3 * c31 + 1] = w1 * iw; wsf[32 + 3 * c31 + 2] = w2 * iw; }
        }
        LDS_WAIT(); asm volatile("" ::: "memory");
        LAS bf16* stg = (LAS bf16*)wl;
#pragma unroll
        for (int r = 0; r < 16; ++r) { const int qr = crow(r, hi); const float rl = wsf[qr];
            const unsigned pk = cvtpk(o[0][r] * rl, o[1][r] * rl);
            stg[qr * 64 + c31] = (bf16)(pk & 0xffffu); stg[qr * 64 + 32 + c31] = (bf16)(pk >> 16); }
        LDS_WAIT(); asm volatile("" ::: "memory");
        if (PH == 0) {
            bf16* Odst = (g == 0) ? MIXp : O1p;
#pragma unroll
            for (int i = 0; i < 4; ++i) { const int row = i * 8 + (lane >> 3), ch = lane & 7; const v4u v = *(const LAS v4u*)(stg + row * 64 + ch * 8);
                *(GAS v4u*)(Odst + (rowb + (size_t)((m0 + row) * dil + res)) * 1024 + h * 64 + ch * 8) = v; }
            if (hi == 0) LSE[((size_t)g * M + rowb + tq) * NH + h] = mx + __builtin_amdgcn_logf(ls);
        } else {
#pragma unroll
            for (int i = 0; i < 4; ++i) { const int row = i * 8 + (lane >> 3), ch = lane & 7;
                a0w = wsf[32 + 3 * row + 0]; a1w = wsf[32 + 3 * row + 1]; a2w = wsf[32 + 3 * row + 2];
                const size_t off = (rowb + (size_t)((m0 + row) * dil + res)) * 1024 + h * 64 + ch * 8;
                float f0[8], f1[8], f2[8]; unpack8(m0w[i], f0); unpack8(o1w[i], f1); unpack8(*(const LAS v4u*)(stg + row * 64 + ch * 8), f2);
                float y[8];
#pragma unroll
                for (int e = 0; e < 8; ++e) y[e] = a0w * f0[e] + a1w * f1[e] + a2w * f2[e];
                v4u ov; ov.x = pk2(y[0], y[1]); ov.y = pk2(y[2], y[3]); ov.z = pk2(y[4], y[5]); ov.w = pk2(y[6], y[7]);
                *(GAS v4u*)(MIXp + off) = ov; }
        }
        LDS_WAIT(); asm volatile("" ::: "memory");
    }
    __syncthreads();
#undef ATT_CHUNK
#undef ATT_LOADCHUNK
#undef ATT_LOADQ
}
}

__device__ __forceinline__ void final_norm_pass(Frame& F, const bf16* xb, const float* g, float* out) {
    const int gw = F.vcu * NWAVES + F.wave;
    f32x4 gv[4];
#pragma unroll
    for (int q = 0; q < 2; ++q) { gv[2 * q] = ((const GAS f32x4*)g)[128 * q + 2 * F.lane]; gv[2 * q + 1] = ((const GAS f32x4*)g)[128 * q + 2 * F.lane + 1]; }
    v4u xw[8][2];
#pragma unroll
    for (int kk = 0; kk < 8; ++kk) { const int m = SEQ * (gw >> 8) + (gw & 255) + 256 * kk; const GAS v4u* xr = (const GAS v4u*)(xb + (size_t)m * D) + F.lane; xw[kk][0] = xr[0]; xw[kk][1] = xr[64]; }
#pragma unroll
    for (int kk = 0; kk < 8; ++kk) { const int m = SEQ * (gw >> 8) + (gw & 255) + 256 * kk;
        float v[2][8]; float s = 0.f;
#pragma unroll
        for (int q = 0; q < 2; ++q) { unpack8(xw[kk][q], v[q]);
#pragma unroll
            for (int e = 0; e < 8; ++e) s += v[q][e] * v[q][e]; }
        const float rstd = 1.0f / sqrtf(wave_sum(s) * (1.0f / D) + 1e-6f);
        GAS f32x4* o = (GAS f32x4*)(out + (size_t)m * D);
#pragma unroll
        for (int q = 0; q < 2; ++q) {
            __builtin_nontemporal_store((f32x4){v[q][0], v[q][1], v[q][2], v[q][3]} * rstd * gv[2 * q], &o[128 * q + 2 * F.lane]);
            __builtin_nontemporal_store((f32x4){v[q][4], v[q][5], v[q][6], v[q][7]} * rstd * gv[2 * q + 1], &o[128 * q + 2 * F.lane + 1]); }
    }
}


constexpr int RSTD_OFF = RING_BYTES;
constexpr int XPOSE_OFF = RSTD_OFF + 6144;
static_assert(XPOSE_OFF + 8 * 2048 <= LDSCTL_OFF, "epilogue turn slots");
struct RstdOrder : pg8::StaticOrder {
    float p[3][4]; LAS float* tab; int tid;
    __device__ __forceinline__ void load(Frame& F, const float* ssq) {
        tab = (LAS float*)(F.lds + RSTD_OFF); tid = F.tid;
        pg8::Unit u;
#pragma unroll
        for (int k = 0; k < 3; ++k) { const int ui = 2 * k + (tid >> 8);
            if (next(ui, u)) { const int row = u.pm * 256 + (tid & 255);
#pragma unroll
                for (int q = 0; q < 4; ++q) p[k][q] = ssq[(size_t)q * M + row]; }
            else {
#pragma unroll
                for (int q = 0; q < 4; ++q) p[k][q] = 1.0f; } }
    }
    __device__ __forceinline__ void after_first_stage() const {
#pragma unroll
        for (int k = 0; k < 3; ++k) tab[(2 * k + (tid >> 8)) * 256 + (tid & 255)] = __builtin_amdgcn_rsqf(((p[k][0] + p[k][1]) + (p[k][2] + p[k][3])) * (1.0f / 1024.0f) + 1e-6f);
    }
};

struct EpiResFinal {
    static constexpr bool PERM = true, AFTER_DRAIN = true;
    const bf16* xb; float* ssq; const float* gfin; float* out; const XcdBarrier* bar; unsigned* lseq; bool local_mode; bool do_final;
    __device__ __forceinline__ void fused(pg8::f32x4 (&acc)[2][2][4][2], const pg8::Unit& u, int wr, int wc, int fr, int fq, LAS unsigned char* lds, int wid, int lane) const {
        LAS float* Pt = (LAS float*)lds;
        LAS float* Rt = (LAS float*)(lds + 4096);
        const int col0 = u.pn * 256 + wc * 32 + 8 * fq;
        pg8::u32x4 xr[2][4][2];
#pragma unroll
        for (int ai = 0; ai < 2; ++ai)
#pragma unroll
            for (int m = 0; m < 4; ++m) { const size_t off = (size_t)(u.pm * 256 + ai * 128 + wr * 64 + m * 16 + fr) * 1024 + col0;
#pragma unroll
                for (int bj = 0; bj < 2; ++bj) xr[ai][m][bj] = *(const pg8::u32x4*)(xb + off + bj * 128); }
#pragma unroll
        for (int ai = 0; ai < 2; ++ai)
#pragma unroll
            for (int m = 0; m < 4; ++m) { const int rl = ai * 128 + wr * 64 + m * 16 + fr; float s = 0.f;
#pragma unroll
                for (int bj = 0; bj < 2; ++bj) { pg8::f32x4 x0, x1; pg8::unpack8f(xr[ai][m][bj], x0, x1);
                    const pg8::f32x4 v0 = acc[ai][bj][m][0] + x0, v1 = acc[ai][bj][m][1] + x1;
                    acc[ai][bj][m][0] = v0; acc[ai][bj][m][1] = v1;
                    s += (v0[0] * v0[0] + v0[1] * v0[1]) + (v0[2] * v0[2] + v0[3] * v0[3]) + (v1[0] * v1[0] + v1[1] * v1[1]) + (v1[2] * v1[2] + v1[3] * v1[3]); }
                s += __shfl_xor(s, 16); s += __shfl_xor(s, 32);
                if (fq == 0) Pt[rl * 4 + wc] = s; }
        LDS_WAIT(); __syncthreads();
        const int t = wid * 64 + lane;
        if (t < 256) { const pg8::f32x4 p = *(const LAS pg8::f32x4*)(Pt + t * 4); ssq[(size_t)u.pn * M + u.pm * 256 + t] = (p[0] + p[1]) + (p[2] + p[3]); }
        if (!do_final) return;
        if (local_mode) xcc_local_barrier(*bar, *lseq); else xcd_barrier(*bar);
        if (t < 256) { const int row = u.pm * 256 + t;
            const float sq = (ssq[row] + ssq[(size_t)M + row]) + (ssq[(size_t)2 * M + row] + ssq[(size_t)3 * M + row]);
            Rt[t] = 1.0f / sqrtf(sq * (1.0f / D) + 1e-6f); }
        pg8::f32x4 gv[2][2];
#pragma unroll
        for (int bj = 0; bj < 2; ++bj) { gv[bj][0] = *(const GAS pg8::f32x4*)(gfin + col0 + bj * 128); gv[bj][1] = *(const GAS pg8::f32x4*)(gfin + col0 + bj * 128 + 4); }
        LDS_WAIT(); __syncthreads();
#pragma unroll
        for (int ai = 0; ai < 2; ++ai)
#pragma unroll
            for (int m = 0; m < 4; ++m) { const int rl = ai * 128 + wr * 64 + m * 16 + fr; const float rs = Rt[rl];
                float* orow = out + (size_t)(u.pm * 256 + rl) * 1024 + col0;
#pragma unroll
                for (int bj = 0; bj < 2; ++bj) {
                    __builtin_nontemporal_store(acc[ai][bj][m][0] * rs * gv[bj][0], (GAS pg8::f32x4*)(orow + bj * 128));
                    __builtin_nontemporal_store(acc[ai][bj][m][1] * rs * gv[bj][1], (GAS pg8::f32x4*)(orow + bj * 128 + 4)); } }
    }
};

#ifndef ATTN_SIMPLE
#define ATTN_SIMPLE 0
#endif
#ifndef DUP_G1
#define DUP_G1 0
#endif
#ifndef DUP_G3
#define DUP_G3 0
#endif
#ifndef DUP_P0
#define DUP_P0 0
#endif
#ifndef DUP_BAR
#define DUP_BAR 0
#endif
#ifndef NO_LOCAL
#define NO_LOCAL 0
#endif
#ifndef DUP_ATT
#define DUP_ATT 0
#endif
#ifndef DUP_CONV
#define DUP_CONV 0
#endif
constexpr int NPHASE = 2 + 6 * DEPTH;
struct Args { const float* in[13]; float* out; unsigned char* ws; int ph_lo, ph_hi; };
__global__ void __launch_bounds__(NWAVES * 64, 2) mk_fwd(Args args) {
    extern __shared__ __attribute__((aligned(16))) unsigned char lds[];
    Frame F;
    F.lds = (LAS unsigned char*)lds;
    F.MISC = (volatile LAS unsigned*)(F.lds + MISC_OFF);
    F.tid = threadIdx.x; F.lane = F.tid & 63; F.wave = __builtin_amdgcn_readfirstlane(F.tid >> 6);
    F.G = gridDim.x; { const int bx = blockIdx.x; F.vcu = (F.G % 8 == 0) ? (bx % 8) * (F.G / 8) + bx / 8 : bx; }
    unsigned char* ws = args.ws;
    F.ctl = (gu32*)(ws + WS_CTL);
    Ptrs P;
    P.x = args.in[0]; P.mix_norm = args.in[1]; P.ffn_norm = args.in[2]; P.final_norm = args.in[3]; P.conv_w_in = args.in[4]; P.conv_kernel = args.in[5]; P.conv_w_out = args.in[6];
    P.attn_w_qkv = args.in[7]; P.attn_w_out = args.in[8]; P.rel_bias = args.in[9]; P.w_gate = args.in[10]; P.w_up = args.in[11]; P.w_down = args.in[12]; P.out = args.out; P.ws = ws;
    for (int u = F.tid; u < (LDS_BYTES - LDSCTL_OFF) / 4; u += NWAVES * 64) ((LAS unsigned*)(F.lds + LDSCTL_OFF))[u] = 0u;
    __syncthreads();
    XcdBarrier bar = xcd_barrier_post((unsigned*)(F.ctl + CW_BAR), F.MISC + 8);
    int cid = (int)blockIdx.x;
    bool local_mode = false; unsigned lseq = 0u;
    bf16* XB = (bf16*)(ws + WS_XB); float* SSQ = (float*)(ws + WS_SSQ); bf16* ACT = (bf16*)(ws + WS_ACT); bf16* MIX = (bf16*)(ws + WS_MIX);
    const int lo = args.ph_lo, hi = args.ph_hi;
#define IN(k) (lo <= (k) && (k) < hi)
#if DUP_G1
#define REPG1(...) { __VA_ARGS__ __VA_ARGS__ }
#else
#define REPG1(...) __VA_ARGS__
#endif
#if DUP_G3
#define REPG3(...) { __VA_ARGS__ __VA_ARGS__ }
#else
#define REPG3(...) __VA_ARGS__
#endif
#if DUP_ATT
#define REPATT(...) { __VA_ARGS__ __syncthreads(); __VA_ARGS__ }
#else
#define REPATT(...) __VA_ARGS__
#endif
#if DUP_CONV
#define REPCONV(...) { __VA_ARGS__ __syncthreads(); __VA_ARGS__ }
#else
#define REPCONV(...) __VA_ARGS__
#endif
#define SEAMG(k) do { if (IN(k) && IN((k) + 1)) { xcd_barrier(bar); if (DUP_BAR) xcd_barrier(bar); } } while (0)
#define SEAM(k) do { if (IN(k) && IN((k) + 1)) { if (local_mode) xcc_local_barrier(bar, lseq); else xcd_barrier(bar); if (DUP_BAR) { if (local_mode) xcc_local_barrier(bar, lseq); else xcd_barrier(bar); } } } while (0)
    if (IN(0)) { p0_prologue(F, P); if (DUP_P0) { __syncthreads(); p0_prologue(F, P); } } SEAMG(0);
    if (lo == 0 && hi == NPHASE && F.G == 256 && !NO_LOCAL) {
        if (F.tid == 0) { unsigned ok = 1u;
#pragma unroll
            for (unsigned jx = 0; jx < 16; ++jx) { const unsigned cx = xb_ld(&bar.bar[XB_XCNT(jx)]); ok &= (cx == (jx < 8u ? 32u : 0u)) ? 1u : 0u; }
            F.MISC[11] = ok; }
        __syncthreads();
        local_mode = F.MISC[11] != 0u;
        if (local_mode) { const int rank = (int)F.MISC[10], xcc = (int)bar.x; cid = rank * 8 + xcc; F.vcu = xcc * 32 + rank; }
    }
#define LAYER(li) do { \
        constexpr int j = (li) >> 1; constexpr bool is_attn = ((li) & 1) != 0; constexpr int p0 = 1 + 6 * (li); \
        const unsigned char* wl = ws + WS_W + (size_t)(li) * W_LAYER; \
        if (IN(p0)) REPG1({ pg8::Gemm g{XB, (const bf16*)(wl + W_IN_OFF), M, 3072, 1024}; RstdOrder S; S.init(M, 3072, F.G, cid); S.load(F, SSQ); \
            if (is_attn) { pg8::EpiQKV E{ACT, (const LAS float*)(F.lds + RSTD_OFF), C2, F.lds + XPOSE_OFF}; pg8::gemm_phase<pg8::EpiQKV, RstdOrder, true, true>(F.lds + RING_OFF, g, S, E); } \
            else { pg8::EpiConvIn E{ACT, ACT + (size_t)M * 1024, (const LAS float*)(F.lds + RSTD_OFF), F.lds + XPOSE_OFF}; pg8::gemm_phase<pg8::EpiConvIn, RstdOrder, true, true>(F.lds + RING_OFF, g, S, E); } }) \
        SEAM(p0); \
        if (IN(p0 + 1)) { if (is_attn) REPATT({ if (ATTN_SIMPLE) attn_simple(F, ACT, P.rel_bias, MIX); else att::attn_phase<0>(F, ACT, P.rel_bias, MIX, (bf16*)P.out, (float*)((char*)P.out + 32 * MiB)); }) \
                          else REPCONV({ conv_pass(F, ACT, ACT + (size_t)M * 1024, P.conv_kernel + (size_t)j * 3 * 1024, MIX); }) } \
        SEAM(p0 + 1); \
        if (is_attn && !ATTN_SIMPLE) { if (IN(p0 + 2)) att::attn_phase<1>(F, ACT, P.rel_bias, MIX, (bf16*)P.out, (float*)((char*)P.out + 32 * MiB)); SEAM(p0 + 2); } \
        if (IN(p0 + 3)) { pg8::Gemm g{MIX, (const bf16*)(wl + W_OUT_OFF), M, 1024, 1024}; pg8::StaticOrder S; S.init(M, 1024, F.G, cid); \
            pg8::EpiRes E{XB, SSQ}; pg8::gemm_phase<pg8::EpiRes, pg8::StaticOrder, false, true>(F.lds + RING_OFF, g, S, E); } \
        SEAM(p0 + 3); \
        if (IN(p0 + 4)) REPG3({ pg8::Gemm g{XB, (const bf16*)(wl + W_GU_OFF), M, 5632, 1024}; RstdOrder S; S.init(M, 5632, F.G, cid); S.load(F, SSQ); \
            pg8::EpiSwiGLU E{ACT, (const LAS float*)(F.lds + RSTD_OFF), F.lds + XPOSE_OFF}; pg8::gemm_phase<pg8::EpiSwiGLU, RstdOrder, true, true>(F.lds + RING_OFF, g, S, E); }) \
        if (IN(p0 + 4)) { if ((li) + 1 < DEPTH && cid >= 128) { __syncthreads(); convert_layer_weights(F, P, (li) + 1, (cid - 128) * NWAVES + F.wave, 128 * NWAVES, 0); } }   \
        SEAM(p0 + 4); \
        if (IN(p0 + 5)) { pg8::Gemm g{ACT, (const bf16*)(wl + W_DN_OFF), M, 1024, 2816}; pg8::StaticOrder S; S.init(M, 1024, F.G, cid); \
            if ((li) + 1 < DEPTH) { pg8::EpiRes E{XB, SSQ}; pg8::gemm_phase<pg8::EpiRes, pg8::StaticOrder, false, true>(F.lds + RING_OFF, g, S, E); } \
            else { EpiResFinal E{XB, SSQ, P.final_norm, P.out, &bar, &lseq, local_mode, IN(NPHASE - 1)}; pg8::gemm_phase<EpiResFinal, pg8::StaticOrder, false, true>(F.lds + RING_OFF, g, S, E); } } \
        if ((li) + 1 < DEPTH) SEAMG(p0 + 5); \
    } while (0)
    LAYER(0); LAYER(1); LAYER(2); LAYER(3);
}

#ifndef MK_PER_PHASE
#define MK_PER_PHASE 0
#endif
extern "C" void kernel_launch(void* const* d_in, const int* in_sizes, int n_in, void* d_out, int out_size, void* d_ws, size_t ws_size, hipStream_t stream) {
    static int grid = 0;
    if (grid == 0) {
        if (n_in != 13 || in_sizes[0] != M * D || out_size != M * D || ws_size < WS_END) { fprintf(stderr, "kernel_launch: unexpected shapes (n_in %d, in0 %d, out %d, ws %zu)\n", n_in, n_in > 0 ? in_sizes[0] : -1, out_size, ws_size); grid = -1; return; }
        int dev = 0, cus = 0, per_cu = 0;
        if (hipGetDevice(&dev) != hipSuccess || hipDeviceGetAttribute(&cus, hipDeviceAttributeMultiprocessorCount, dev) != hipSuccess) { grid = -1; return; }
        if (hipFuncSetAttribute((const void*)mk_fwd, hipFuncAttributeMaxDynamicSharedMemorySize, LDS_BYTES) != hipSuccess) { fprintf(stderr, "kernel_launch: hipFuncSetAttribute failed\n"); grid = -1; return; }
        if (hipOccupancyMaxActiveBlocksPerMultiprocessor(&per_cu, (const void*)mk_fwd, NWAVES * 64, LDS_BYTES) != hipSuccess || per_cu < 1) { fprintf(stderr, "kernel_launch: occupancy query says %d blocks per CU\n", per_cu); (void)hipGetLastError(); grid = -1; return; }
        grid = cus;
        if (grid != 256) fprintf(stderr, "kernel_launch: %d CUs; this kernel is laid out for 256\n", grid);
    }
    if (grid < 0) return;
    (void)hipMemsetAsync((char*)d_ws + WS_CTL, 0, CTL_ZERO_BYTES, stream);
    Args a{};
    for (int i = 0; i < 13; ++i) a.in[i] = (const float*)d_in[i];
    a.out = (float*)d_out; a.ws = (unsigned char*)d_ws;
#if MK_PER_PHASE
    for (int ph = 0; ph < NPHASE; ++ph) { a.ph_lo = ph; a.ph_hi = ph + 1; hipLaunchKernelGGL(mk_fwd, dim3(grid), dim3(NWAVES * 64), LDS_BYTES, stream, a); }
#else
    a.ph_lo = 0; a.ph_hi = NPHASE;
    hipLaunchKernelGGL(mk_fwd, dim3(grid), dim3(NWAVES * 64), LDS_BYTES, stream, a);
#endif
}
```

```cpp
#include <hip/hip_runtime.h>
#include <cstdio>
#include <cstdint>
namespace pg8 {
#define PG8_LAS __attribute__((address_space(3)))
typedef unsigned short bf16_t;
typedef short bf16x8 __attribute__((ext_vector_type(8)));
typedef float f32x4 __attribute__((ext_vector_type(4)));
typedef unsigned u32x4 __attribute__((ext_vector_type(4)));
constexpr int BM = 256, BK = 64, HALF = 128, HTB = HALF * BK * 2  , STAGE_BYTES = 8 * HTB, NXCD = 8, WGM = 4;

__host__ __device__ __forceinline__ int lds_byte(int r, int c) { const int st = (r >> 4) * 2 + (c >> 5), rr = r & 15, cc = c & 31, ob = rr * 64 + cc * 2; return st * 1024 + (ob ^ (((ob >> 9) & 1) << 5)); }
__host__ __device__ __forceinline__ void stage_rc(int b, int& R, int& C) { const int st = b / 1024, sb = b % 1024, swz = sb ^ (((sb >> 9) & 1) << 5); R = (st >> 1) * 16 + swz / 64; C = (st & 1) * 32 + (swz % 64) / 2; }
__host__ __device__ __forceinline__ int perm32(int rho) { const int n = rho >> 4, i = rho & 15; return 8 * (i >> 2) + 4 * n + (i & 3); }

struct Unit { int pm, pn, ord; };
struct Gemm { const bf16_t* A; const bf16_t* Bt; int M, N, K; };

struct StaticOrder {
    int nM, nN, nwg, G, c;
    __host__ __device__ void init(int M, int N, int G_, int c_) { nM = M / BM; nN = N / BM; nwg = nM * nN; G = G_; c = c_; }
    __host__ __device__ bool next(int i, Unit& u) const {
        const long L = (long)i * G + c; if (L >= nwg) return false;
        int wgid = (int)L; { const int q = nwg / NXCD, r = nwg % NXCD, xcd = wgid % NXCD, off = wgid / NXCD; wgid = (xcd < r ? xcd * (q + 1) : r * (q + 1) + (xcd - r) * q) + off; }
        const int nig = WGM * nN, gid = wgid / nig, fm = gid * WGM, gsz = (nM - fm) < WGM ? (nM - fm) : WGM;
        u.pm = fm + ((wgid % nig) % gsz); u.pn = (wgid % nig) / gsz; u.ord = i; return true;
    }
    __device__ __forceinline__ void a_ready(const Unit&) const {}
    __device__ __forceinline__ void done(const Unit&) const {}
    __device__ __forceinline__ void after_first_stage() const {}
};

constexpr int MROWS = 16384;
#ifndef USE_F16
#define USE_F16 0
#endif
typedef _Float16 h16x2 __attribute__((ext_vector_type(2))); typedef _Float16 h16x8 __attribute__((ext_vector_type(8))); typedef float f32x2c __attribute__((ext_vector_type(2)));
#if USE_F16
__device__ __forceinline__ unsigned cvt_pk_bf16(float lo, float hi) { const f32x2c v = {lo, hi}; return __builtin_bit_cast(unsigned, __builtin_convertvector(v, h16x2)); }
#define PG8_MFMA16(a, b, c) __builtin_amdgcn_mfma_f32_16x16x32_f16(__builtin_bit_cast(pg8::h16x8, (a)), __builtin_bit_cast(pg8::h16x8, (b)), (c), 0, 0, 0)
#else
typedef __bf16 bf16x2c __attribute__((ext_vector_type(2)));
__device__ __forceinline__ unsigned cvt_pk_bf16(float lo, float hi) { const f32x2c v = {lo, hi}; return __builtin_bit_cast(unsigned, __builtin_convertvector(v, bf16x2c)); }
#define PG8_MFMA16(a, b, c) __builtin_amdgcn_mfma_f32_16x16x32_bf16((a), (b), (c), 0, 0, 0)
#endif
__device__ __forceinline__ u32x4 pack8(const f32x4 v0, const f32x4 v1) { u32x4 w; w.x = cvt_pk_bf16(v0[0], v0[1]); w.y = cvt_pk_bf16(v0[2], v0[3]); w.z = cvt_pk_bf16(v1[0], v1[1]); w.w = cvt_pk_bf16(v1[2], v1[3]); return w; }
__device__ __forceinline__ float row_rstd(const float* ssq, int row) {
    const float s = (ssq[row] + ssq[MROWS + row]) + (ssq[2 * MROWS + row] + ssq[3 * MROWS + row]);
    return __builtin_amdgcn_rsqf(s * (1.0f / 1024.0f) + 1e-6f);
}
#define XPOSE_SETUP(stg_, wr_, wc_, fr_, fq_) const int xp_lane = (fq_) * 16 + (fr_), xp_tr = xp_lane >> 2, xp_tc = xp_lane & 3; PG8_LAS unsigned char* const xp_sl = (stg_) + ((wr_) * 4 + (wc_)) * 2048; \
    const int xp_wo = (fr_) * 64 + (((fq_) ^ ((fr_) >> 2)) << 4), xp_ro = xp_tr * 64 + ((xp_tc ^ (xp_tr >> 2)) << 4)
__device__ __forceinline__ u32x4 xpose_turn(PG8_LAS unsigned char* slot, int wo, int ro, const u32x4 v) { *(PG8_LAS u32x4*)(slot + wo) = v; return *(const PG8_LAS u32x4*)(slot + ro); }
#define XPOSE_TURN(slot_, v_) xpose_turn(xp_sl + (slot_) * 1024, xp_wo, xp_ro, (v_))
struct EpiQKV {
    static constexpr bool PERM = true, AFTER_DRAIN = false;
    bf16_t* O; const PG8_LAS float* rs; float c2; PG8_LAS unsigned char* stg;
    __device__ __forceinline__ void operator()(const f32x4 (&acc)[2][2][4][2], const Unit& u, int wr, int wc, int fr, int fq) const {
        XPOSE_SETUP(stg, wr, wc, fr, fq);
        const int row0 = u.pm * BM + wr * 64 + xp_tr, col0 = u.pn * BM + wc * 32 + 8 * xp_tc;
        const float sc = (u.pn < 4) ? c2 : 1.0f;
#pragma unroll
        for (int ai = 0; ai < 2; ++ai)
#pragma unroll
            for (int m = 0; m < 4; ++m) { const int row = row0 + ai * HALF + m * 16; const float rs = this->rs[u.ord * BM + ai * HALF + wr * 64 + m * 16 + fr] * sc; bf16_t* rowp = O + (size_t)row * 3072 + col0;
#pragma unroll
                for (int bj = 0; bj < 2; ++bj) *(u32x4*)(rowp + bj * HALF) = XPOSE_TURN(bj, pack8(acc[ai][bj][m][0] * rs, acc[ai][bj][m][1] * rs)); }
    }
};
struct EpiConvIn {
    static constexpr bool PERM = true, AFTER_DRAIN = false;
    bf16_t* Bo; bf16_t* CU; const PG8_LAS float* rs; PG8_LAS unsigned char* stg;
    __device__ __forceinline__ void operator()(const f32x4 (&acc)[2][2][4][2], const Unit& u, int wr, int wc, int fr, int fq) const {
        XPOSE_SETUP(stg, wr, wc, fr, fq);
        const int row0 = u.pm * BM + wr * 64 + xp_tr;
        if (u.pn < 4) {
            const int col0 = u.pn * BM + wc * 32 + 8 * xp_tc;
#pragma unroll
            for (int ai = 0; ai < 2; ++ai)
#pragma unroll
                for (int m = 0; m < 4; ++m) { const int row = row0 + ai * HALF + m * 16; const float rs = this->rs[u.ord * BM + ai * HALF + wr * 64 + m * 16 + fr]; bf16_t* rowp = Bo + (size_t)row * 1024 + col0;
#pragma unroll
                    for (int bj = 0; bj < 2; ++bj) *(u32x4*)(rowp + bj * HALF) = XPOSE_TURN(bj, pack8(acc[ai][bj][m][0] * rs, acc[ai][bj][m][1] * rs)); }
        } else {
            const int col0 = (u.pn - 4) * HALF + wc * 32 + 8 * xp_tc;
#pragma unroll
            for (int ai = 0; ai < 2; ++ai)
#pragma unroll
                for (int m = 0; m < 4; ++m) { const int row = row0 + ai * HALF + m * 16; const float rs = this->rs[u.ord * BM + ai * HALF + wr * 64 + m * 16 + fr]; const float rs2 = rs * rs;
                    *(u32x4*)(CU + (size_t)row * 1024 + col0) = XPOSE_TURN(m & 1, pack8(acc[ai][0][m][0] * acc[ai][1][m][0] * rs2, acc[ai][0][m][1] * acc[ai][1][m][1] * rs2)); }
        }
    }
};
__device__ __forceinline__ f32x4 swiglu4(const f32x4 g, const f32x4 u, float rs) {
    const f32x4 gk = g * (rs * -1.4426950408889634f);
    f32x4 t; t[0] = __builtin_amdgcn_exp2f(gk[0]); t[1] = __builtin_amdgcn_exp2f(gk[1]); t[2] = __builtin_amdgcn_exp2f(gk[2]); t[3] = __builtin_amdgcn_exp2f(gk[3]);
    const f32x4 d = t + 1.0f;
    f32x4 r; r[0] = __builtin_amdgcn_rcpf(d[0]); r[1] = __builtin_amdgcn_rcpf(d[1]); r[2] = __builtin_amdgcn_rcpf(d[2]); r[3] = __builtin_amdgcn_rcpf(d[3]);
    return (g * u) * (r * (rs * rs));
}
struct EpiSwiGLU {
    static constexpr bool PERM = true, AFTER_DRAIN = false;
    bf16_t* Hd; const PG8_LAS float* rs; PG8_LAS unsigned char* stg;
    __device__ __forceinline__ void operator()(const f32x4 (&acc)[2][2][4][2], const Unit& u, int wr, int wc, int fr, int fq) const {
        XPOSE_SETUP(stg, wr, wc, fr, fq);
        const int row0 = u.pm * BM + wr * 64 + xp_tr, col0 = u.pn * HALF + wc * 32 + 8 * xp_tc;
#pragma unroll
        for (int ai = 0; ai < 2; ++ai)
#pragma unroll
            for (int m = 0; m < 4; ++m) { const int row = row0 + ai * HALF + m * 16; const float rs = this->rs[u.ord * BM + ai * HALF + wr * 64 + m * 16 + fr];
                *(u32x4*)(Hd + (size_t)row * 2816 + col0) = XPOSE_TURN(m & 1, pack8(swiglu4(acc[ai][0][m][0], acc[ai][1][m][0], rs), swiglu4(acc[ai][0][m][1], acc[ai][1][m][1], rs))); }
    }
};
struct EpiSwiGLUHalf {
    static constexpr bool PERM = true, AFTER_DRAIN = false;
    bf16_t* Hd; const PG8_LAS float* rs; PG8_LAS unsigned char* stg;
    __device__ __forceinline__ void operator()(const f32x4 (&acc)[2][2][4][2], const Unit& u, int wr, int wc, int fr, int fq) const {
        XPOSE_SETUP(stg, wr, wc, fr, fq);
        const int hf = u.ord >> 8;
        const int row0 = u.pm * BM + hf * HALF + wr * 64 + xp_tr, col0 = u.pn * HALF + wc * 32 + 8 * xp_tc;
#pragma unroll
        for (int m = 0; m < 4; ++m) { const int row = row0 + m * 16; const float rs = this->rs[hf * HALF + wr * 64 + m * 16 + fr];
            *(u32x4*)(Hd + (size_t)row * 2816 + col0) = XPOSE_TURN(m & 1, pack8(swiglu4(acc[0][0][m][0], acc[0][1][m][0], rs), swiglu4(acc[0][0][m][1], acc[0][1][m][1], rs))); }
    }
};
__device__ __forceinline__ void unpack8f(const u32x4 w, f32x4& a, f32x4& b) {
#if USE_F16
    const unsigned w0 = w.x, w1 = w.y, w2 = w.z, w3 = w.w;
    const f32x2c p0 = __builtin_convertvector(__builtin_bit_cast(h16x2, w0), f32x2c), p1 = __builtin_convertvector(__builtin_bit_cast(h16x2, w1), f32x2c);
    const f32x2c p2 = __builtin_convertvector(__builtin_bit_cast(h16x2, w2), f32x2c), p3 = __builtin_convertvector(__builtin_bit_cast(h16x2, w3), f32x2c);
    a[0] = p0.x; a[1] = p0.y; a[2] = p1.x; a[3] = p1.y; b[0] = p2.x; b[1] = p2.y; b[2] = p3.x; b[3] = p3.y;
#else
    a[0] = __builtin_bit_cast(float, w.x << 16); a[1] = __builtin_bit_cast(float, w.x & 0xffff0000u); a[2] = __builtin_bit_cast(float, w.y << 16); a[3] = __builtin_bit_cast(float, w.y & 0xffff0000u);
    b[0] = __builtin_bit_cast(float, w.z << 16); b[1] = __builtin_bit_cast(float, w.z & 0xffff0000u); b[2] = __builtin_bit_cast(float, w.w << 16); b[3] = __builtin_bit_cast(float, w.w & 0xffff0000u);
#endif
}
struct EpiRes {
    static constexpr bool PERM = true, AFTER_DRAIN = true;
    bf16_t* xb; float* ssq;
    __device__ __forceinline__ void fused(f32x4 (&acc)[2][2][4][2], const Unit& u, int wr, int wc, int fr, int fq, PG8_LAS unsigned char* lds, int wid, int lane) const {
        PG8_LAS float* P = (PG8_LAS float*)lds;
        const int col0 = u.pn * BM + wc * 32 + 8 * fq;
        u32x4 xr[2][4][2];
#pragma unroll
        for (int ai = 0; ai < 2; ++ai)
#pragma unroll
            for (int m = 0; m < 4; ++m) { const size_t off = (size_t)(u.pm * BM + ai * HALF + wr * 64 + m * 16 + fr) * 1024 + col0;
#pragma unroll
                for (int bj = 0; bj < 2; ++bj) xr[ai][m][bj] = *(const u32x4*)(xb + off + bj * HALF); }
#pragma unroll
        for (int ai = 0; ai < 2; ++ai)
#pragma unroll
            for (int m = 0; m < 4; ++m) { const int rl = ai * HALF + wr * 64 + m * 16 + fr; const size_t off = (size_t)(u.pm * BM + rl) * 1024 + col0; float s = 0.f;
#pragma unroll
                for (int bj = 0; bj < 2; ++bj) { f32x4 x0, x1; unpack8f(xr[ai][m][bj], x0, x1);
                    const f32x4 v0 = acc[ai][bj][m][0] + x0, v1 = acc[ai][bj][m][1] + x1;
                    *(u32x4*)(xb + off + bj * HALF) = pack8(v0, v1);
                    s += (v0[0] * v0[0] + v0[1] * v0[1]) + (v0[2] * v0[2] + v0[3] * v0[3]) + (v1[0] * v1[0] + v1[1] * v1[1]) + (v1[2] * v1[2] + v1[3] * v1[3]); }
                s += __shfl_xor(s, 16); s += __shfl_xor(s, 32);
                if (fq == 0) P[rl * 4 + wc] = s; }
        asm volatile("s_waitcnt lgkmcnt(0)" ::: "memory"); __builtin_amdgcn_s_barrier(); asm volatile("" ::: "memory");
        const int t = wid * 64 + lane;
        if (t < 256) { const f32x4 p = *(const PG8_LAS f32x4*)(P + t * 4); ssq[(size_t)u.pn * MROWS + u.pm * BM + t] = (p[0] + p[1]) + (p[2] + p[3]); }
    }
};

template <class Epi, class Sched, bool ALIGN_EPI = false, bool SP2 = false, bool HALFM = false>
__device__ __forceinline__ void gemm_phase(PG8_LAS unsigned char* lds, const Gemm g, const Sched& S, const Epi& E) {
    const int tid = threadIdx.x, wid = __builtin_amdgcn_readfirstlane(tid >> 6), lane = tid & 63, wr = wid >> 2, wc = wid & 3, fr = lane & 15, fq = lane >> 4;
    const int K = g.K, nt = K / BK;
    unsigned voffA[2], voffB[2];
#pragma unroll
    for (int i = 0; i < 2; ++i) { int R, C; stage_rc(tid * 16 + i * 8192, R, C); const int Rb = Epi::PERM ? ((R & ~31) + perm32(R & 31)) : R;
        voffA[i] = (unsigned)(R * K + C) * 2u; voffB[i] = (unsigned)(Rb * K + C) * 2u; }
    const size_t kstep = (size_t)(BK * 2);
    const size_t hstep = (size_t)HALF * K * 2;
    const size_t tstep = 2 * hstep;
    const unsigned ldsw = (unsigned)wid * 1024u;
    const int aoff = lds_byte(wr * 64 + fr, fq * 8), boff = lds_byte(wc * 32 + fr, fq * 8);
#define PG8_SA(b, h) (((b) * 2 + (h)) * HTB)
#define PG8_SB(b, h) ((4 + (b) * 2 + (h)) * HTB)
#define PG8_STAGE(bufoff, gbase, voff) do { _Pragma("unroll") for (int _i = 0; _i < 2; ++_i) \
        __builtin_amdgcn_global_load_lds((const unsigned*)((const char*)(gbase) + (voff)[_i]), (PG8_LAS unsigned*)(lds + (bufoff) + ldsw + _i * 8192), 16, 0, 0); } while (0)
#define PG8_LDA(dst, b, h) do { _Pragma("unroll") for (int m = 0; m < 4; ++m) _Pragma("unroll") for (int k = 0; k < 2; ++k) dst[m][k] = *(const PG8_LAS bf16x8*)(lds + PG8_SA(b, h) + aoff + m * 2048 + k * 1024); } while (0)
#define PG8_LDB(dst, b, h) do { _Pragma("unroll") for (int n = 0; n < 2; ++n) _Pragma("unroll") for (int k = 0; k < 2; ++k) dst[n][k] = *(const PG8_LAS bf16x8*)(lds + PG8_SB(b, h) + boff + n * 2048 + k * 1024); } while (0)
#define PG8_MMA(ai, bj, At, Bt) do { __builtin_amdgcn_s_setprio(1); _Pragma("unroll") for (int m = 0; m < 4; ++m) _Pragma("unroll") for (int n = 0; n < 2; ++n) _Pragma("unroll") for (int k = 0; k < 2; ++k) \
        acc[ai][bj][m][n] = PG8_MFMA16(Bt[n][k], At[m][k], acc[ai][bj][m][n]); __builtin_amdgcn_s_setprio(0); } while (0)
#define PG8_WAIT_V(n) asm volatile("s_waitcnt vmcnt(" #n ")" ::: "memory")
#define PG8_WAIT_L(n) asm volatile("s_waitcnt lgkmcnt(" #n ")" ::: "memory")
#define PG8_BAR __builtin_amdgcn_s_barrier()
#define PG8_SCHED __builtin_amdgcn_sched_barrier(0)
    Unit cur, nxt; int ui = 0;
    if (!S.next(0, cur)) return;
    f32x4 acc[2][2][4][2];
#pragma unroll
    for (int a = 0; a < 2; ++a)
#pragma unroll
        for (int b = 0; b < 2; ++b)
#pragma unroll
            for (int m = 0; m < 4; ++m)
#pragma unroll
                for (int n = 0; n < 2; ++n) acc[a][b][m][n] = (f32x4){0.f, 0.f, 0.f, 0.f};
    bf16x8 At[4][2], B0[2][2], B1[2][2];
    const char* cA = (const char*)g.A + (size_t)cur.pm * tstep + (HALFM ? (size_t)(cur.ord >> 8) * hstep : (size_t)0); const char* cB = (const char*)g.Bt + (size_t)cur.pn * tstep;
    S.a_ready(cur);
    if constexpr (SP2) {
        PG8_STAGE(PG8_SB(0, 0), cB, voffB); PG8_STAGE(PG8_SB(0, 1), cB + hstep, voffB); PG8_STAGE(PG8_SA(0, 0), cA, voffA); PG8_STAGE(PG8_SA(0, 1), cA + hstep, voffA);
        S.after_first_stage();
        if (wr == 1) PG8_BAR;
        PG8_WAIT_V(2); PG8_BAR;
        PG8_STAGE(PG8_SB(1, 0), cB + kstep, voffB); PG8_STAGE(PG8_SA(1, 0), cA + kstep, voffA); PG8_STAGE(PG8_SB(1, 1), cB + hstep + kstep, voffB);
        PG8_WAIT_V(6); PG8_BAR;
    } else {
        PG8_STAGE(PG8_SB(0, 0), cB, voffB); PG8_STAGE(PG8_SA(0, 0), cA, voffA); PG8_STAGE(PG8_SB(0, 1), cB + hstep, voffB); PG8_STAGE(PG8_SA(0, 1), cA + hstep, voffA);
        if (wr == 1) PG8_BAR;
        PG8_WAIT_V(4); PG8_BAR;
        PG8_STAGE(PG8_SB(1, 0), cB + kstep, voffB); PG8_STAGE(PG8_SA(1, 0), cA + kstep, voffA); PG8_STAGE(PG8_SB(1, 1), cB + hstep + kstep, voffB);
        PG8_WAIT_V(6); PG8_BAR;
    }
    for (;;) {
        const bool has_next = S.next(ui + 1, nxt);
        const char* nA = has_next ? (const char*)g.A + (size_t)nxt.pm * tstep + (HALFM ? (size_t)(nxt.ord >> 8) * hstep : (size_t)0) : cA; const char* nB = has_next ? (const char*)g.Bt + (size_t)nxt.pn * tstep : cB;
        for (int t = 0; t < nt; t += 2) {
            const bool last = (t == nt - 2);
            const char* a1 = cA + (size_t)(t + 1) * kstep;
            const char* a2 = last ? nA : cA + (size_t)(t + 2) * kstep; const char* b2 = last ? nB : cB + (size_t)(t + 2) * kstep;
            const char* a3 = a2 + kstep; const char* b3 = b2 + kstep;
            if (last && has_next) S.a_ready(nxt);
            if constexpr (SP2) {
            PG8_LDB(B0, 0, 0); PG8_LDB(B1, 0, 1); PG8_SCHED; PG8_LDA(At, 0, 0); PG8_STAGE(PG8_SA(1, 1), a1 + hstep, voffA);
            PG8_WAIT_V(8); PG8_WAIT_L(0); PG8_BAR; PG8_MMA(0, 0, At, B0); PG8_MMA(0, 1, At, B1); PG8_BAR; PG8_SCHED;
            if constexpr (!HALFM) PG8_LDA(At, 0, 1); PG8_STAGE(PG8_SB(0, 0), b2, voffB); PG8_STAGE(PG8_SB(0, 1), b2 + hstep, voffB); PG8_STAGE(PG8_SA(0, 0), a2, voffA);
            PG8_WAIT_V(8); PG8_WAIT_L(0); PG8_BAR; if constexpr (!HALFM) { PG8_MMA(1, 0, At, B0); PG8_MMA(1, 1, At, B1); } PG8_BAR; PG8_SCHED;
            PG8_LDB(B0, 1, 0); PG8_LDB(B1, 1, 1); PG8_SCHED; PG8_LDA(At, 1, 0); PG8_STAGE(PG8_SA(0, 1), a2 + hstep, voffA);
            PG8_WAIT_V(8); PG8_WAIT_L(0); PG8_BAR; PG8_MMA(0, 0, At, B0); PG8_MMA(0, 1, At, B1); PG8_BAR; PG8_SCHED;
            if constexpr (!HALFM) PG8_LDA(At, 1, 1); PG8_STAGE(PG8_SB(1, 0), b3, voffB); PG8_STAGE(PG8_SB(1, 1), b3 + hstep, voffB); PG8_STAGE(PG8_SA(1, 0), a3, voffA);
            PG8_WAIT_V(8); PG8_WAIT_L(0); PG8_BAR; if constexpr (!HALFM) { PG8_MMA(1, 0, At, B0); PG8_MMA(1, 1, At, B1); } PG8_BAR; PG8_SCHED;
            } else {
            PG8_LDB(B0, 0, 0); PG8_SCHED; PG8_LDA(At, 0, 0); PG8_STAGE(PG8_SA(1, 1), a1 + hstep, voffA);
            PG8_WAIT_L(8); PG8_BAR; PG8_WAIT_L(0); PG8_MMA(0, 0, At, B0); PG8_BAR; PG8_SCHED;
            PG8_LDB(B1, 0, 1); PG8_STAGE(PG8_SB(0, 0), b2, voffB);
            PG8_BAR; PG8_WAIT_L(0); PG8_MMA(0, 1, At, B1); PG8_BAR;
            PG8_LDA(At, 0, 1); PG8_STAGE(PG8_SA(0, 0), a2, voffA);
            PG8_BAR; PG8_WAIT_L(0); PG8_MMA(1, 0, At, B0); PG8_BAR; PG8_SCHED;
            PG8_STAGE(PG8_SB(0, 1), b2 + hstep, voffB);
            PG8_WAIT_V(6); PG8_BAR; PG8_MMA(1, 1, At, B1); PG8_BAR;
            PG8_LDB(B0, 1, 0); PG8_SCHED; PG8_LDA(At, 1, 0); PG8_STAGE(PG8_SA(0, 1), a2 + hstep, voffA);
            PG8_WAIT_L(8); PG8_BAR; PG8_WAIT_L(0); PG8_MMA(0, 0, At, B0); PG8_BAR; PG8_SCHED;
            PG8_LDB(B1, 1, 1); PG8_STAGE(PG8_SB(1, 0), b3, voffB);
            PG8_BAR; PG8_WAIT_L(0); PG8_MMA(0, 1, At, B1); PG8_BAR;
            PG8_LDA(At, 1, 1); PG8_STAGE(PG8_SA(1, 0), a3, voffA);
            PG8_BAR; PG8_WAIT_L(0); PG8_MMA(1, 0, At, B0); PG8_BAR; PG8_SCHED;
            PG8_STAGE(PG8_SB(1, 1), b3 + hstep, voffB);
            PG8_WAIT_V(6); PG8_BAR; PG8_MMA(1, 1, At, B1); PG8_BAR;
            }
        }
        if constexpr (ALIGN_EPI) { if (wr == 0) PG8_BAR; }
        if constexpr (!Epi::AFTER_DRAIN) { E(acc, cur, wr, wc, fr, fq);
#if defined(DUP_EPI)
            asm volatile("" ::: "memory"); E(acc, cur, wr, wc, fr, fq);
#endif
            S.done(cur); }
        if (!has_next) break;
#pragma unroll
        for (int a = 0; a < 2; ++a)
#pragma unroll
            for (int b = 0; b < 2; ++b)
#pragma unroll
                for (int m = 0; m < 4; ++m)
#pragma unroll
                    for (int n = 0; n < 2; ++n) acc[a][b][m][n] = (f32x4){0.f, 0.f, 0.f, 0.f};
        cur = nxt; cA = nA; cB = nB; ++ui;
        if constexpr (ALIGN_EPI) { if (wr == 1) PG8_BAR; }
    }
    PG8_WAIT_V(0);
    if constexpr (!ALIGN_EPI) { if (wr == 0) PG8_BAR; }
    PG8_BAR;
    if constexpr (Epi::AFTER_DRAIN) { E.fused(acc, cur, wr, wc, fr, fq, lds, wid, lane); S.done(cur); }
#undef PG8_SA
#undef PG8_SB
#undef PG8_STAGE
#undef PG8_LDA
#undef PG8_LDB
#undef PG8_MMA
#undef PG8_WAIT_V
#undef PG8_WAIT_L
#undef PG8_BAR
#undef PG8_SCHED
}
}

constexpr int NWAVES = 8;
constexpr int BATCH = 8, SEQ = 2048, D = 1024, DEPTH = 4, NH = 16, HD = 64, FF = 2816, NB = 32;
constexpr int M = BATCH * SEQ;
constexpr float C2 = 0.125f * 1.4426950408889634f;
constexpr float LOG2E = 1.4426950408889634f;

constexpr size_t MiB = 1u << 20;
constexpr size_t WS_CTL = 0, CTL_ZERO_BYTES = 64 * 1024;
constexpr size_t WS_SSQ = 1 * MiB;
constexpr size_t WS_W = 2 * MiB;
constexpr size_t W_IN_OFF = 0, W_OUT_OFF = (size_t)3072 * 1024 * 2, W_GU_OFF = W_OUT_OFF + (size_t)1024 * 1024 * 2, W_DN_OFF = W_GU_OFF + (size_t)5632 * 1024 * 2;
constexpr size_t W_LAYER = W_DN_OFF + (size_t)1024 * 2816 * 2;
constexpr size_t WS_XB = 100 * MiB;
constexpr size_t WS_ACT = 132 * MiB;
constexpr size_t WS_MIX = 228 * MiB;
constexpr size_t WS_END = 260 * MiB;
static_assert(WS_W + 4 * W_LAYER <= WS_XB && WS_MIX + (size_t)M * D * 2 <= WS_END, "d_ws map");
constexpr int CW_TMO = 0;
constexpr int CW_BAR = 1024;

constexpr int RING_OFF = 0, RING_BYTES = 131072;
constexpr int LDS_BYTES = 163840;
constexpr int LDSCTL_OFF = LDS_BYTES - 1024, MISC_OFF = LDSCTL_OFF + 320;

#define GAS __attribute__((address_space(1)))
#define LAS __attribute__((address_space(3)))
typedef unsigned short bf16;
typedef unsigned v4u __attribute__((ext_vector_type(4)));
typedef float f32x4 __attribute__((ext_vector_type(4)));
typedef GAS unsigned gu32;
#define RLX_AGENT __ATOMIC_RELAXED, __HIP_MEMORY_SCOPE_AGENT
#define LDS_WAIT() asm volatile("s_waitcnt lgkmcnt(0)" ::: "memory")
#define VM_WAIT() asm volatile("s_waitcnt vmcnt(0)" ::: "memory")
#if USE_F16
__device__ __forceinline__ unsigned f2bf(float f) { return (unsigned)__builtin_bit_cast(unsigned short, (_Float16)f); }
__device__ __forceinline__ unsigned pk2(float lo, float hi) { return pg8::cvt_pk_bf16(lo, hi); }
__device__ __forceinline__ float bf2f(unsigned short b) { return (float)__builtin_bit_cast(_Float16, b); }
#else
__device__ __forceinline__ unsigned f2bf(float f) { unsigned u = __builtin_bit_cast(unsigned, f); return (u + 0x7fffu + ((u >> 16) & 1u)) >> 16; }
__device__ __forceinline__ unsigned pk2(float lo, float hi) { return pg8::cvt_pk_bf16(lo, hi); }
__device__ __forceinline__ float bf2f(unsigned short b) { return __builtin_bit_cast(float, (unsigned)b << 16); }
#endif

#define XB_TMO      128
#define XB_XCNT(j)  (256  + 64 * (j))
#define XB_XSUB(j)  (1280 + 64 * (j))
#define XB_XGEN(j)  (2304 + 64 * (j))
#define XB_TOP      3328
#define XB_TOPGEN   3392
#define XCD_BAR_WORDS 3456
#define XB_SPIN_CAP (1u << 18)
__device__ __forceinline__ unsigned xb_ld(unsigned* p)              { return __hip_atomic_load(p, __ATOMIC_RELAXED, __HIP_MEMORY_SCOPE_AGENT); }
__device__ __forceinline__ unsigned xb_add(unsigned* p, unsigned v) { return __hip_atomic_fetch_add(p, v, __ATOMIC_RELAXED, __HIP_MEMORY_SCOPE_AGENT); }
__device__ __forceinline__ unsigned xb_xcc_id() { return (unsigned)__builtin_amdgcn_s_getreg((3 << 11) | 20) & 0xFu; }
#define XB_SPIN(cond, bar) do { unsigned _sp = 0; while (cond) { __builtin_amdgcn_s_sleep(1); \
    if ((++_sp & 255u) == 0u) { if (xb_ld(&(bar)[XB_TMO])) break; if (_sp > XB_SPIN_CAP) { atomicAdd(&(bar)[XB_TMO], 1u); break; } } } } while (0)
struct XcdBarrier { unsigned* bar; unsigned x; volatile LAS unsigned* st; };
#define XB_LOC(j)   (3520 + 64 * (j))
__device__ __forceinline__ XcdBarrier xcd_barrier_post(unsigned* bar, volatile LAS unsigned* st) {
    XcdBarrier b; b.bar = bar; b.x = xb_xcc_id(); b.st = st;
    if (threadIdx.x == 0) st[2] = xb_add(&bar[XB_XCNT(b.x)], 1u);
    return b;
}
__device__ __forceinline__ void xcc_local_barrier(const XcdBarrier& b, unsigned& seq) {
    asm volatile("s_waitcnt vmcnt(0)" ::: "memory");
    __syncthreads();
    if (threadIdx.x == 0) {
        unsigned* bar = b.bar;
        __builtin_amdgcn_s_waitcnt(0);
        __builtin_amdgcn_fence(__ATOMIC_ACQUIRE, "agent");
        xb_add(&bar[XB_LOC(b.x)], 1u);
        const unsigned target = 32u * (seq + 1u);
        XB_SPIN(xb_ld(&bar[XB_LOC(b.x)]) < target, bar);
        asm volatile("s_waitcnt vmcnt(0)" ::: "memory");
    }
    __syncthreads();
    ++seq;
}
__device__ __forceinline__ void xcd_barrier_complete(unsigned* bar, unsigned x, unsigned& nloc, unsigned& nx) {
    const unsigned G = gridDim.x * gridDim.y * gridDim.z;
    unsigned sum, cnt, mine, sp = 0u;
    for (;;) {
        sum = 0u; cnt = 0u; mine = 0u;
#pragma unroll
        for (unsigned j = 0; j < 16; ++j) { const unsigned c = xb_ld(&bar[XB_XCNT(j)]); sum += c; cnt += (c > 0u) ? 1u : 0u; mine = (j == x) ? c : mine; }
        if (sum == G) break;
        __builtin_amdgcn_s_sleep(1);
        if ((++sp & 255u) == 0u) { if (xb_ld(&bar[XB_TMO])) break; if (sp > XB_SPIN_CAP) { atomicAdd(&bar[XB_TMO], 1u); break; } }
    }
    nloc = mine > 0u ? mine : 1u; nx = cnt > 0u ? cnt : 1u;
}
__device__ __forceinline__ void xcd_barrier(const XcdBarrier& b) {
    asm volatile("s_waitcnt vmcnt(0)" ::: "memory");
    __syncthreads();
    if (threadIdx.x == 0) {
        unsigned* bar = b.bar;
        __builtin_amdgcn_s_waitcnt(0);
        unsigned nloc = b.st[0], nx = b.st[1];
        if (nloc == 0u) { xcd_barrier_complete(bar, b.x, nloc, nx); b.st[0] = nloc; b.st[1] = nx; }
        const unsigned old = xb_add(&bar[XB_XSUB(b.x)], 1u);
        const unsigned gen = old / nloc;
        if (old + 1u == (gen + 1u) * nloc) {
            __builtin_amdgcn_fence(__ATOMIC_RELEASE, "agent");
            asm volatile("s_waitcnt vmcnt(0)" ::: "memory");
            const unsigned og = xb_add(&bar[XB_TOP], 1u);
            const unsigned tg = og / nx;
            if (og + 1u == (tg + 1u) * nx) xb_add(&bar[XB_TOPGEN], 1u);
            else XB_SPIN(xb_ld(&bar[XB_TOPGEN]) == tg, bar);
            __builtin_amdgcn_fence(__ATOMIC_ACQUIRE, "agent");
            xb_add(&bar[XB_XGEN(b.x)], 1u);
            asm volatile("s_waitcnt vmcnt(0)" ::: "memory");
        } else {
            XB_SPIN(xb_ld(&bar[XB_XGEN(b.x)]) == gen, bar);
            __builtin_amdgcn_fence(__ATOMIC_ACQUIRE, "agent");
            asm volatile("s_waitcnt vmcnt(0)" ::: "memory");
        }
    }
    __syncthreads();
}

struct Frame {
    LAS unsigned char* lds;
    volatile LAS unsigned* MISC;
    gu32* ctl;
    int tid, lane, wave, vcu, G;
};
__device__ __forceinline__ float wave_sum(float v) {
#pragma unroll
    for (int o = 1; o < 64; o <<= 1) v += __shfl_xor(v, o);
    return v;
}
__device__ __forceinline__ float wave_max(float v) {
#pragma unroll
    for (int o = 1; o < 64; o <<= 1) v = fmaxf(v, __shfl_xor(v, o));
    return v;
}

__device__ __forceinline__ void p0_transpose_item(const float* W, int K, int N, bf16* WT, int orow0, const float* gain, LAS unsigned char* T, int k0, int n0, int lane) {
    const int kq = lane >> 4, nl = (lane & 15) * 4;
    const GAS f32x4* src = (const GAS f32x4*)(W + (size_t)(k0 + 16 * kq) * N + n0 + nl);
    f32x4 v[16];
#pragma unroll
    for (int i = 0; i < 16; ++i) v[i] = __builtin_nontemporal_load(&src[(size_t)i * (N / 4)]);
    if (gain) {
        const GAS f32x4* gp = (const GAS f32x4*)(gain + k0 + 16 * kq);
#pragma unroll
        for (int q = 0; q < 4; ++q) { const f32x4 gq = gp[q];
#pragma unroll
            for (int e = 0; e < 4; ++e) v[4 * q + e] = v[4 * q + e] * gq[e]; }
    }
#pragma unroll
    for (int j = 0; j < 4; ++j) {
        const int n = nl + j, sw = (n >> 2) & 7;
        v4u a, b;
        a.x = pk2(v[0][j], v[1][j]); a.y = pk2(v[2][j], v[3][j]); a.z = pk2(v[4][j], v[5][j]); a.w = pk2(v[6][j], v[7][j]);
        b.x = pk2(v[8][j], v[9][j]); b.y = pk2(v[10][j], v[11][j]); b.z = pk2(v[12][j], v[13][j]); b.w = pk2(v[14][j], v[15][j]);
        *(LAS v4u*)(T + n * 128 + (((2 * kq) ^ sw) << 4)) = a;
        *(LAS v4u*)(T + n * 128 + (((2 * kq + 1) ^ sw) << 4)) = b;
    }
    LDS_WAIT(); asm volatile("" ::: "memory");
#pragma unroll
    for (int i = 0; i < 8; ++i) { const int n = 8 * i + (lane >> 3), c = lane & 7;
        const v4u o = *(const LAS v4u*)(T + n * 128 + ((c ^ ((n >> 2) & 7)) << 4));
        *(GAS v4u*)(WT + (size_t)(orow0 + n) * K + k0 + 8 * c) = o; }
    LDS_WAIT(); asm volatile("" ::: "memory");
}
struct Ptrs {
    const float *x, *mix_norm, *ffn_norm, *final_norm, *conv_w_in, *conv_kernel, *conv_w_out, *attn_w_qkv, *attn_w_out, *rel_bias, *w_gate, *w_up, *w_down;
    float* out; unsigned char* ws;
};
__device__ __forceinline__ void convert_layer_weights(Frame& F, const Ptrs& P, int li, int gw, int NGW, int part  ) {
    LAS unsigned char* scr = F.lds + RING_OFF + F.wave * 8192;
    constexpr int I_IN = 16 * 48, I_OUT = 16 * 16, I_G = 16 * 44, I_DN = 44 * 16, I_LAYER = I_IN + I_OUT + 2 * I_G + I_DN;
    const int j = li >> 1;
    bf16* wl = (bf16*)(P.ws + WS_W + (size_t)li * W_LAYER);
    const int it_lo = (part == 2) ? I_LAYER / 2 : 0, it_hi = (part == 1) ? I_LAYER / 2 : I_LAYER;
    for (int it = it_lo + gw; it < it_hi; it += NGW) {
        int r = it;
        if (r < I_IN) {
            const int kb = r / 48, nb = r % 48, n0 = nb * 64;
            if ((li & 1) == 0) {
                int orow; if (n0 < 1024) orow = n0; else if (n0 < 2048) { const int f = n0 - 1024; orow = 1024 + 256 * (f >> 7) + (f & 127); } else { const int f = n0 - 2048; orow = 1024 + 256 * (f >> 7) + 128 + (f & 127); }
                p0_transpose_item(P.conv_w_in + (size_t)j * 1024 * 3072, 1024, 3072, (bf16*)((char*)wl + W_IN_OFF), orow, P.mix_norm + li * 1024, scr, kb * 64, n0, F.lane);
            } else {
                p0_transpose_item(P.attn_w_qkv + (size_t)j * 1024 * 3072, 1024, 3072, (bf16*)((char*)wl + W_IN_OFF), n0, P.mix_norm + li * 1024, scr, kb * 64, n0, F.lane);
            }
            continue;
        }
        r -= I_IN;
        if (r < I_OUT) {
            const int kb = r / 16, nb = r % 16;
            const float* src = ((li & 1) == 0) ? P.conv_w_out + (size_t)j * 1024 * 1024 : P.attn_w_out + (size_t)j * 1024 * 1024;
            p0_transpose_item(src, 1024, 1024, (bf16*)((char*)wl + W_OUT_OFF), nb * 64, nullptr, scr, kb * 64, nb * 64, F.lane);
            continue;
        }
        r -= I_OUT;
        if (r < 2 * I_G) {
            const int up = r >= I_G; if (up) r -= I_G;
            const int kb = r / 44, nb = r % 44, n0 = nb * 64;
            const int orow = 256 * (n0 >> 7) + (up ? 128 : 0) + (n0 & 127);
            p0_transpose_item((up ? P.w_up : P.w_gate) + (size_t)li * 1024 * 2816, 1024, 2816, (bf16*)((char*)wl + W_GU_OFF), orow, P.ffn_norm + li * 1024, scr, kb * 64, n0, F.lane);
            continue;
        }
        r -= 2 * I_G;
        { const int kb = r / 16, nb = r % 16;
          p0_transpose_item(P.w_down + (size_t)li * 2816 * 1024, 2816, 1024, (bf16*)((char*)wl + W_DN_OFF), nb * 64, nullptr, scr, kb * 64, nb * 64, F.lane); }
    }
}
__device__ __forceinline__ void p0_prologue(Frame& F, const Ptrs& P) {
    const int gw = F.vcu * NWAVES + F.wave, NGW = F.G * NWAVES;
    bf16* xb = (bf16*)(P.ws + WS_XB); float* ssq = (float*)(P.ws + WS_SSQ);
    f32x4 xv[4][2][4];
#pragma unroll
    for (int tr = 0; tr < 4; ++tr) { const int m = 2 * gw + 2 * NGW * tr;
        if (m < M) {
#pragma unroll
            for (int rr = 0; rr < 2; ++rr) { const GAS f32x4* xr = (const GAS f32x4*)(P.x + (size_t)(m + rr) * D) + F.lane;
#pragma unroll
                for (int q = 0; q < 4; ++q) xv[tr][rr][q] = __builtin_nontemporal_load(&xr[64 * q]); } } }
    convert_layer_weights(F, P, 0, gw, NGW, 0);
#define P0_ROWS(v_, m_) do { float s[2] = {0.f, 0.f}; \
        _Pragma("unroll") for (int rr = 0; rr < 2; ++rr) { \
            _Pragma("unroll") for (int q = 0; q < 4; ++q) s[rr] += (v_[rr][q].x * v_[rr][q].x + v_[rr][q].y * v_[rr][q].y) + (v_[rr][q].z * v_[rr][q].z + v_[rr][q].w * v_[rr][q].w); \
            s[rr] = wave_sum(s[rr]); \
            GAS unsigned long long* o8 = (GAS unsigned long long*)(xb + (size_t)((m_) + rr) * D) + F.lane; \
            _Pragma("unroll") for (int q = 0; q < 4; ++q) o8[64 * q] = (unsigned long long)pk2(v_[rr][q].x, v_[rr][q].y) | ((unsigned long long)pk2(v_[rr][q].z, v_[rr][q].w) << 32); \
            if (F.lane < 4) ssq[(size_t)F.lane * M + (m_) + rr] = (F.lane == 0) ? s[rr] : 0.f; } } while (0)
#pragma unroll
    for (int tr = 0; tr < 4; ++tr) { const int m = 2 * gw + 2 * NGW * tr; if (m < M) P0_ROWS(xv[tr], m); }
    for (int m = 2 * gw + 8 * NGW; m < M; m += 2 * NGW) {
        f32x4 v[2][4];
#pragma unroll
        for (int rr = 0; rr < 2; ++rr) { const GAS f32x4* xr = (const GAS f32x4*)(P.x + (size_t)(m + rr) * D) + F.lane;
#pragma unroll
            for (int q = 0; q < 4; ++q) v[rr][q] = __builtin_nontemporal_load(&xr[64 * q]); }
        P0_ROWS(v, m);
    }
#undef P0_ROWS
}

__device__ __forceinline__ void unpack8(const v4u w, float (&f)[8]) {
    f32x4 a, b; pg8::unpack8f(w, a, b);
    f[0] = a[0]; f[1] = a[1]; f[2] = a[2]; f[3] = a[3]; f[4] = b[0]; f[5] = b[1]; f[6] = b[2]; f[7] = b[3];
}
__device__ __forceinline__ void conv_pass(Frame& F, const bf16* Bo, const bf16* CU, const float* ck, bf16* G) {
    const int nthr = F.G * NWAVES * 64;
    for (int item = F.vcu * (NWAVES * 64) + F.tid; item < (M / 16) * 128; item += nthr) {
        const int cg = item & 127, rb = item >> 7, t0 = rb * 16, c0 = cg * 8;
        float k0[8], k1[8], k2[8];
#pragma unroll
        for (int i = 0; i < 8; ++i) { k0[i] = ck[c0 + i]; k1[i] = ck[1024 + c0 + i]; k2[i] = ck[2048 + c0 + i]; }
        float p2[8], p1[8];
        if ((t0 & (SEQ - 1)) == 0) {
#pragma unroll
            for (int i = 0; i < 8; ++i) { p2[i] = 0.f; p1[i] = 0.f; }
        } else {
            unpack8(*(const GAS v4u*)(CU + (size_t)(t0 - 2) * 1024 + c0), p2); unpack8(*(const GAS v4u*)(CU + (size_t)(t0 - 1) * 1024 + c0), p1);
        }
        v4u cw[16], bw[16];
#pragma unroll
        for (int r = 0; r < 16; ++r) { cw[r] = *(const GAS v4u*)(CU + (size_t)(t0 + r) * 1024 + c0); bw[r] = *(const GAS v4u*)(Bo + (size_t)(t0 + r) * 1024 + c0); }
#pragma unroll
        for (int r = 0; r < 16; ++r) {
            float cur[8], bb[8]; unpack8(cw[r], cur); unpack8(bw[r], bb);
            float g[8];
#pragma unroll
            for (int i = 0; i < 8; ++i) { g[i] = bb[i] * (k0[i] * p2[i] + k1[i] * p1[i] + k2[i] * cur[i]); p2[i] = p1[i]; p1[i] = cur[i]; }
            v4u o; o.x = pk2(g[0], g[1]); o.y = pk2(g[2], g[3]); o.z = pk2(g[4], g[5]); o.w = pk2(g[6], g[7]);
            *(GAS v4u*)(G + (size_t)(t0 + r) * 1024 + c0) = o;
        }
    }
}

__device__ __forceinline__ int t5_bucket(int d) {
    if (d < 16) return d;
    int b = 16;
    b += (d >= 22); b += (d >= 30); b += (d >= 40); b += (d >= 54); b += (d >= 73); b += (d >= 99); b += (d >= 134); b += (d >= 182);
    b += (d >= 246); b += (d >= 332); b += (d >= 450); b += (d >= 609); b += (d >= 825); b += (d >= 1117); b += (d >= 1513);
    return b;
}
__device__ __forceinline__ void attn_simple(Frame& F, const bf16* QKV, const float* rel_bias, bf16* O) {
    LAS float* qs = (LAS float*)(F.lds + RING_OFF + F.wave * 4096);
    LAS float* ps = qs + 64;
    const int gw = F.vcu * NWAVES + F.wave, NGW = F.G * NWAVES, lane = F.lane;
    for (int pair = gw; pair < M * NH; pair += NGW) {
        const int tok = pair >> 4, h = pair & 15, t = tok & (SEQ - 1), rowbase = tok - t;
        qs[lane] = bf2f(QKV[(size_t)tok * 3072 + h * 64 + lane]);
        LDS_WAIT(); asm volatile("" ::: "memory");
        float sv[7]; float mx = -1e30f;
#pragma unroll
        for (int rnd = 0; rnd < 7; ++rnd) {
            const int e = rnd * 64 + lane; const int g = e / 129, j = e - g * 129; const int dil = (g == 0) ? 1 : (g == 1) ? 4 : 16; const int tk = t - j * dil;
            float s = -1e30f;
            if (e < 387 && tk >= 0) {
                const GAS v4u* kr = (const GAS v4u*)(QKV + (size_t)(rowbase + tk) * 3072 + 1024 + h * 64);
                float dot = 0.f;
#pragma unroll
                for (int c = 0; c < 8; ++c) { float kf[8]; unpack8(kr[c], kf);
#pragma unroll
                    for (int i = 0; i < 8; ++i) dot += qs[c * 8 + i] * kf[i]; }
                s = dot + rel_bias[t5_bucket(j * dil) * NH + h] * LOG2E;
            }
            sv[rnd] = s; mx = fmaxf(mx, s);
        }
        mx = wave_max(mx);
        float sum = 0.f;
#pragma unroll
        for (int rnd = 0; rnd < 7; ++rnd) { const float p = __builtin_amdgcn_exp2f(sv[rnd] - mx); sum += p; ps[rnd * 64 + lane] = p; }
        sum = wave_sum(sum);
        LDS_WAIT(); asm volatile("" ::: "memory");
        float acc = 0.f;
        for (int g = 0; g < 3; ++g) { const int dil = (g == 0) ? 1 : (g == 1) ? 4 : 16;
            for (int j = 0; j < 129; ++j) { const int tk = t - j * dil; if (tk < 0) break;
                acc += ps[g * 129 + j] * bf2f(QKV[(size_t)(rowbase + tk) * 3072 + 2048 + h * 64 + lane]); } }
        O[(size_t)tok * 1024 + h * 64 + lane] = (bf16)f2bf(acc / sum);
        LDS_WAIT(); asm volatile("" ::: "memory");
    }
}


#ifndef FORCE_SLOWSM
#define FORCE_SLOWSM 0
#endif
namespace att {
constexpr bool FASTSM = (USE_F16 == 0);
typedef short bf16x8 __attribute__((ext_vector_type(8)));
typedef short s16x4 __attribute__((ext_vector_type(4)));
typedef short v4i16_t __attribute__((ext_vector_type(4)));
typedef float f32x16 __attribute__((ext_vector_type(16)));
typedef float f32x2_t __attribute__((ext_vector_type(2))); typedef __bf16 bf16x2_t __attribute__((ext_vector_type(2)));
constexpr int KIMG_OFF = 0, VIMG_OFF = 49152, WL_OFF = 98304, WL_BYTES = 5120, TBL_OFF = WL_OFF + 8 * WL_BYTES;
constexpr int TBL_CP = 208, TBL_G = 4 * TBL_CP;
static_assert(TBL_OFF + 3 * TBL_G * 4 <= LDSCTL_OFF, "attention LDS map");
__device__ __forceinline__ int crow(int r, int hi) { return (r & 3) + 8 * (r >> 2) + 4 * hi; }
__device__ __forceinline__ unsigned cvtpk(float lo, float hi) { return pg8::cvt_pk_bf16(lo, hi); }
#if USE_F16
#define ATT_MFMA32(a, b, c) __builtin_amdgcn_mfma_f32_32x32x16_f16(__builtin_bit_cast(pg8::h16x8, (a)), __builtin_bit_cast(pg8::h16x8, (b)), (c), 0, 0, 0)
#else
#define ATT_MFMA32(a, b, c) __builtin_amdgcn_mfma_f32_32x32x16_bf16((a), (b), (c), 0, 0, 0)
#endif
__device__ __forceinline__ s16x4 vtr(const LAS unsigned char* p) { return __builtin_bit_cast(s16x4, __builtin_amdgcn_ds_read_tr16_b64_v4i16((LAS v4i16_t*)p)); }
__device__ __forceinline__ void build_tables(Frame& F, const float* rel_bias, int h) {
    LAS float* tbl = (LAS float*)(F.lds + TBL_OFF);
    for (int i = F.tid; i < 3 * TBL_G; i += NWAVES * 64) { const int g = i / TBL_G, e = i % TBL_G, s = e / TBL_CP, m = e % TBL_CP; const int n = m + s, rel = 159 - n;
        const int dil = (g == 0) ? 1 : (g == 1) ? 4 : 16;
        tbl[i] = (n < 192 && rel >= 0 && rel <= 128) ? rel_bias[t5_bucket(rel * dil) * NH + h] * LOG2E : -1e30f; }
}
template <int PH>
__device__ __forceinline__ void attn_phase(Frame& F, const bf16* QKV, const float* rel_bias, bf16* MIXp, bf16* O1p, float* LSE) {
    const int bh = F.vcu >> 1, c = F.vcu & 1, b = bh >> 4, h = bh & 15, w = F.wave, lane = F.lane;
    const int c31 = lane & 31, hi = lane >> 5;
    const size_t rowb = (size_t)b * SEQ;
    LAS unsigned char* Kimg = F.lds + KIMG_OFF; LAS unsigned char* Vimg = F.lds + VIMG_OFF;
    LAS unsigned char* wl = F.lds + WL_OFF + w * WL_BYTES;
    LAS float* wsf = (LAS float*)(wl + 4096);
    const LAS float* tblb = (const LAS float*)(F.lds + TBL_OFF);
    constexpr int NCH = (PH == 0) ? 8 : 4;
#define ATT_CHUNK(ci_, g_, resA_, resB_, c0_) do { if (PH == 0) { const int id_ = c + 2 * (ci_); \
            if (id_ < 8) { g_ = 0; resA_ = 0; c0_ = 256 * id_; } else { g_ = 1; resA_ = (id_ - 8) >> 1; c0_ = 256 * (((id_ - 8) & 1) ^ (((id_ - 8) >> 1) & 1)); } resB_ = resA_; } \
        else { const int id_ = c * 4 + (ci_); g_ = 2; resA_ = 2 * id_; resB_ = 2 * id_ + 1; c0_ = 0; } } while (0)
    const int lane_lr = (w < 4) ? 8 * w + (lane >> 3) : 16 * ((w - 4) & 1) + (lane >> 2);
    const int lane_co = (w < 4) ? 1024 + h * 64 + 8 * ((lane & 7) ^ ((4 * (w & 1) + (lane >> 4)) & 7)) : 2048 + h * 64 + 32 * ((w - 4) >> 1) + 8 * (lane & 3);
#define ATT_LOADCHUNK(ci_) do { int g_, ra_, rb_, c0_; ATT_CHUNK(ci_, g_, ra_, rb_, c0_); const int dil_ = (g_ == 0) ? 1 : (g_ == 1) ? 4 : 16; (void)rb_; \
        const size_t stride_ = (size_t)32 * dil_ * 3072; \
        if (PH == 0) { const bf16* base_ = QKV + ((long)rowb + (long)((c0_ - 128 + lane_lr) * dil_ + ra_)) * 3072 + lane_co; \
            if (c0_ != 0) { _Pragma("unroll") for (int i = 0; i < 4; ++i) pre[i] = *(const GAS v4u*)(base_ + i * stride_); } \
            _Pragma("unroll") for (int i = 4; i < 12; ++i) pre[i] = *(const GAS v4u*)(base_ + i * stride_); } \
        else { const bf16* base_ = QKV + (rowb + (size_t)(lane_lr * dil_ + ra_)) * 3072 + lane_co; \
            _Pragma("unroll") for (int i = 4; i < 8; ++i) { pre[i] = *(const GAS v4u*)(base_ + (i - 4) * stride_); pre[i + 4] = *(const GAS v4u*)(base_ + 3072 + (i - 4) * stride_); } } } while (0)
    v4u pre[12];
#define ATT_LOADQ(ci_) do { int g_, ra_, rb_, c0_; ATT_CHUNK(ci_, g_, ra_, rb_, c0_); const int dil_ = (g_ == 0) ? 1 : (g_ == 1) ? 4 : 16; \
        const int res_ = (PH == 1 && w >= 4) ? rb_ : ra_; const int m0_ = (PH == 1) ? 32 * ((w < 4) ? w : 7 - w) : c0_ + 32 * w; \
        const bf16* qp_ = QKV + (rowb + (size_t)((m0_ + c31) * dil_ + res_)) * 3072 + h * 64 + 8 * hi; \
        _Pragma("unroll") for (int s = 0; s < 4; ++s) qf[s] = *(const bf16x8*)(qp_ + 16 * s); } while (0)
    ATT_LOADCHUNK(0);
    if (PH == 0) build_tables(F, rel_bias, h);
    for (int ci = 0; ci < NCH; ++ci) {
        int g, resA, resB, c0; ATT_CHUNK(ci, g, resA, resB, c0);
        const int dil = (g == 0) ? 1 : (g == 1) ? 4 : 16;
        const int res = (PH == 1 && w >= 4) ? resB : resA;
        const int m0 = (PH == 1) ? 32 * ((w < 4) ? w : 7 - w) : c0 + 32 * w;
        const int tb0 = (PH == 1) ? ((w < 4) ? 0 : 4) + (m0 >> 5) : w;
        const int nskip = (m0 >= 128) ? 0 : 4 - (m0 >> 5);
        bf16x8 qf[4]; ATT_LOADQ(ci);
        __syncthreads();
        { LAS unsigned char* dst = ((w < 4) ? Kimg + w * 1024 : Vimg + (w - 4) * 1024) + lane * 16;
          if (PH == 0 && c0 != 0) {
#pragma unroll
            for (int i = 0; i < 4; ++i) *(LAS v4u*)(dst + i * 4096) = pre[i]; }
#pragma unroll
          for (int i = 4; i < 12; ++i) *(LAS v4u*)(dst + i * 4096) = pre[i]; }
        const int tq = (m0 + c31) * dil + res;
        float l0n = 0.f, l1n = 0.f;
        if (PH == 1) { l0n = LSE[(rowb + tq) * NH + h]; l1n = LSE[((size_t)M + rowb + tq) * NH + h]; }
        LDS_WAIT();
        __syncthreads();
        if (ci + 1 < NCH) ATT_LOADCHUNK(ci + 1);
        float mx = 0.f, ls = 0.f;
        f32x16 o[2];
        float zacc = 0.f; asm volatile("" : "+v"(zacc));
#pragma unroll
        for (int r = 0; r < 16; ++r) { o[0][r] = zacc; o[1][r] = zacc; }
        const int loff = ((lane >> 4) & 1) * 32 + (lane & 3) * 8 + (4 * hi + ((lane & 15) >> 2)) * 64;
        const int ta = 31 - c31 + 4 * hi, ts = ta & 3; const LAS f32x4* tb = (const LAS f32x4*)(tblb + g * TBL_G + ts * TBL_CP + (ta - ts));
        const LAS unsigned char* kbase = Kimg + tb0 * 4096 + c31 * 128; const LAS unsigned char* vbase = Vimg + tb0 * 4096;
#define ATT_QK(dst, kt_) do { const LAS f32x4* tq_ = tb + 8 * (kt_); _Pragma("unroll") for (int j = 0; j < 4; ++j) { const f32x4 t4 = tq_[2 * j]; dst[4 * j + 0] = t4[0]; dst[4 * j + 1] = t4[1]; dst[4 * j + 2] = t4[2]; dst[4 * j + 3] = t4[3]; } \
                const LAS unsigned char* kp_ = kbase + (kt_) * 4096; \
                _Pragma("unroll") for (int s = 0; s < 4; ++s) { const bf16x8 kf = *(const LAS bf16x8*)(kp_ + (((2 * s + hi) ^ ((c31 >> 1) & 7)) << 4)); dst = ATT_MFMA32(kf, qf[s], dst); } } while (0)
#define ATT_PV(a_, kt_) do { const LAS unsigned char* slot = vbase + (kt_) * 4096; \
                _Pragma("unroll") for (int ks = 0; ks < 2; ++ks) { \
                    v4u pw; pw.x = cvtpk(a_[8 * ks + 0], a_[8 * ks + 1]); pw.y = cvtpk(a_[8 * ks + 2], a_[8 * ks + 3]); pw.z = cvtpk(a_[8 * ks + 4], a_[8 * ks + 5]); pw.w = cvtpk(a_[8 * ks + 6], a_[8 * ks + 7]); \
                    const bf16x8 pa = __builtin_bit_cast(bf16x8, pw); \
                    osum = ATT_MFMA32(ones, pa, osum); \
                    _Pragma("unroll") for (int dh = 0; dh < 2; ++dh) { \
                        const s16x4 lo = vtr(slot + (dh * 2 + ks) * 1024 + loff), hh = vtr(slot + (dh * 2 + ks) * 1024 + loff + 512); \
                        const bf16x8 vb = (bf16x8){lo[0], lo[1], lo[2], lo[3], hh[0], hh[1], hh[2], hh[3]}; \
                        o[dh] = ATT_MFMA32(pa, vb, o[dh]); } } } while (0)
        f32x16 osum;
#pragma unroll
        for (int r = 0; r < 16; ++r) osum[r] = zacc;
        bf16x8 ones = (bf16x8){(short)0x3F80, (short)0x3F80, (short)0x3F80, (short)0x3F80, (short)0x3F80, (short)0x3F80, (short)0x3F80, (short)0x3F80};
        asm volatile("" : "+v"(ones));
        if (FASTSM) {
            int kt = 4; f32x16 an; ATT_QK(an, 4);
            for (;;) {
                f32x16 a = an;
                const int kn = (kt > nskip) ? kt - 1 : kt;
                ATT_QK(an, kn);
#pragma unroll
                for (int r = 0; r < 16; ++r) a[r] = __builtin_amdgcn_exp2f(a[r]);
                ATT_PV(a, kt);
                if (kt == nskip) break;
                --kt;
            }
            ls = osum[0];
        }
        { const float lt = ls;
          const bool redo = !FASTSM || FORCE_SLOWSM || !(lt > 1e-30f && lt < 1e30f);
          if (__builtin_expect(__any(redo), !FASTSM || FORCE_SLOWSM)) {
            mx = -1e30f;
            for (int kt = 4; kt >= nskip; --kt) { f32x16 a; ATT_QK(a, kt);
#pragma unroll
                for (int r = 0; r < 16; ++r) mx = fmaxf(mx, a[r]); }
            mx = fmaxf(mx, __shfl_xor(mx, 32));
            { float z = 0.f; asm volatile("" : "+v"(z));
#pragma unroll
              for (int r = 0; r < 16; ++r) { o[0][r] = z; o[1][r] = z; osum[r] = z; } }
            for (int kt = 4; kt >= nskip; --kt) { f32x16 a; ATT_QK(a, kt);
#pragma unroll
                for (int r = 0; r < 16; ++r) a[r] = __builtin_amdgcn_exp2f(a[r] - mx);
                ATT_PV(a, kt); }
            ls = osum[0];
          }
        }
#undef ATT_QK
#undef ATT_PV
        v4u m0w[4], o1w[4];
        if (PH == 1) {
#pragma unroll
            for (int i = 0; i < 4; ++i) { const int row = i * 8 + (lane >> 3), ch = lane & 7;
                const size_t off = (rowb + (size_t)((m0 + row) * dil + res)) * 1024 + h * 64 + ch * 8;
                m0w[i] = *(const GAS v4u*)(MIXp + off); o1w[i] = *(const GAS v4u*)(O1p + off); }
        }
        if (hi == 0) wsf[c31] = __builtin_amdgcn_rcpf(ls);
        float a0w = 0.f, a1w = 0.f, a2w = 0.f;
        if (PH == 1) {
            const float l2 = mx + __builtin_amdgcn_logf(ls), l0 = l0n, l1 = l1n;
            const float mm = fmaxf(l2, fmaxf(l0, l1)); const float w0 = __builtin_amdgcn_exp2f(l0 - mm), w1 = __builtin_amdgcn_exp2f(l1 - mm), w2 = __builtin_amdgcn_exp2f(l2 - mm);
            const float iw = __builtin_amdgcn_rcpf(w0 + w1 + w2);
            if (hi == 0) { wsf[32 + 3 * c31 + 0] = w0 * iw; wsf[32 + 3 * c31 + 1] = w1 * iw; wsf[32 + 3 * c31 + 2] = w2 * iw; }
        }
        LDS_WAIT(); asm volatile("" ::: "memory");
        LAS bf16* stg = (LAS bf16*)wl;
#pragma unroll
        for (int r = 0; r < 16; ++r) { const int qr = crow(r, hi); const float rl = wsf[qr];
            const unsigned pk = cvtpk(o[0][r] * rl, o[1][r] * rl);
            stg[qr * 64 + c31] = (bf16)(pk & 0xffffu); stg[qr * 64 + 32 + c31] = (bf16)(pk >> 16); }
        LDS_WAIT(); asm volatile("" ::: "memory");
        if (PH == 0) {
            bf16* Odst = (g == 0) ? MIXp : O1p;
#pragma unroll
            for (int i = 0; i < 4; ++i) { const int row = i * 8 + (lane >> 3), ch = lane & 7; const v4u v = *(const LAS v4u*)(stg + row * 64 + ch * 8);
                *(GAS v4u*)(Odst + (rowb + (size_t)((m0 + row) * dil + res)) * 1024 + h * 64 + ch * 8) = v; }
            if (hi == 0) LSE[((size_t)g * M + rowb + tq) * NH + h] = mx + __builtin_amdgcn_logf(ls);
        } else {
#pragma unroll
            for (int i = 0; i < 4; ++i) { const int row = i * 8 + (lane >> 3), ch = lane & 7;
                a0w = wsf[32 + 3 * row + 0]; a1w = wsf[32 + 3 * row + 1]; a2w = wsf[32 + 3 * row + 2];
                const size_t off = (rowb + (size_t)((m0 + row) * dil + res)) * 1024 + h * 64 + ch * 8;
                float f0[8], f1[8], f2[8]; unpack8(m0w[i], f0); unpack8(o1w[i], f1); unpack8(*(const LAS v4u*)(stg + row * 64 + ch * 8), f2);
                float y[8];
#pragma unroll
                for (int e = 0; e < 8; ++e) y[e] = a0w * f0[e] + a1w * f1[e] + a2w * f2[e];
                v4u ov; ov.x = pk2(y[0], y[1]); ov.y = pk2(y[2], y[3]); ov.z = pk2(y[4], y[5]); ov.w = pk2(y[6], y[7]);
                *(GAS v4u*)(MIXp + off) = ov; }
        }
        LDS_WAIT(); asm volatile("" ::: "memory");
    }
    __syncthreads();
#undef ATT_CHUNK
#undef ATT_LOADCHUNK
#undef ATT_LOADQ
}
}

__device__ __forceinline__ void final_norm_pass(Frame& F, const bf16* xb, const float* g, float* out) {
    const int gw = F.vcu * NWAVES + F.wave;
    f32x4 gv[4];
#pragma unroll
    for (int q = 0; q < 2; ++q) { gv[2 * q] = ((const GAS f32x4*)g)[128 * q + 2 * F.lane]; gv[2 * q + 1] = ((const GAS f32x4*)g)[128 * q + 2 * F.lane + 1]; }
    v4u xw[8][2];
#pragma unroll
    for (int kk = 0; kk < 8; ++kk) { const int m = SEQ * (gw >> 8) + (gw & 255) + 256 * kk; const GAS v4u* xr = (const GAS v4u*)(xb + (size_t)m * D) + F.lane; xw[kk][0] = xr[0]; xw[kk][1] = xr[64]; }
#pragma unroll
    for (int kk = 0; kk < 8; ++kk) { const int m = SEQ * (gw >> 8) + (gw & 255) + 256 * kk;
        float v[2][8]; float s = 0.f;
#pragma unroll
        for (int q = 0; q < 2; ++q) { unpack8(xw[kk][q], v[q]);
#pragma unroll
            for (int e = 0; e < 8; ++e) s += v[q][e] * v[q][e]; }
        const float rstd = 1.0f / sqrtf(wave_sum(s) * (1.0f / D) + 1e-6f);
        GAS f32x4* o = (GAS f32x4*)(out + (size_t)m * D);
#pragma unroll
        for (int q = 0; q < 2; ++q) {
            __builtin_nontemporal_store((f32x4){v[q][0], v[q][1], v[q][2], v[q][3]} * rstd * gv[2 * q], &o[128 * q + 2 * F.lane]);
            __builtin_nontemporal_store((f32x4){v[q][4], v[q][5], v[q][6], v[q][7]} * rstd * gv[2 * q + 1], &o[128 * q + 2 * F.lane + 1]); }
    }
}


constexpr int RSTD_OFF = RING_BYTES;
constexpr int XPOSE_OFF = RSTD_OFF + 6144;
static_assert(XPOSE_OFF + 8 * 2048 <= LDSCTL_OFF, "epilogue turn slots");
struct RstdOrder : pg8::StaticOrder {
    float p[3][4]; LAS float* tab; int tid; int cap = 1 << 20;
    __device__ __forceinline__ bool next(int i, pg8::Unit& u) const { return i < cap && pg8::StaticOrder::next(i, u); }
    __device__ __forceinline__ void load(Frame& F, const float* ssq) {
        tab = (LAS float*)(F.lds + RSTD_OFF); tid = F.tid;
        pg8::Unit u;
#pragma unroll
        for (int k = 0; k < 3; ++k) { const int ui = 2 * k + (tid >> 8);
            if (next(ui, u)) { const int row = u.pm * 256 + (tid & 255);
#pragma unroll
                for (int q = 0; q < 4; ++q) p[k][q] = ssq[(size_t)q * M + row]; }
            else {
#pragma unroll
                for (int q = 0; q < 4; ++q) p[k][q] = 1.0f; } }
    }
    __device__ __forceinline__ void after_first_stage() const {
#pragma unroll
        for (int k = 0; k < 3; ++k) tab[(2 * k + (tid >> 8)) * 256 + (tid & 255)] = __builtin_amdgcn_rsqf(((p[k][0] + p[k][1]) + (p[k][2] + p[k][3])) * (1.0f / 1024.0f) + 1e-6f);
    }
};

struct HalfOrder {
    pg8::StaticOrder S6; int hf; float p[4]; LAS float* tab; int tid;
    __device__ __forceinline__ void init(int G, int cid) { S6.init(M, 5632, G, 8 * ((cid >> 3) >> 1) + (cid & 7)); hf = (cid >> 3) & 1; }
    __device__ __forceinline__ bool next(int i, pg8::Unit& u) const { if (i != 0 || !S6.next(5, u)) return false; u.ord = hf << 8; return true; }
    __device__ __forceinline__ void load(Frame& F, const float* ssq) {
        tab = (LAS float*)(F.lds + RSTD_OFF); tid = F.tid;
        pg8::Unit u;
        if (tid < 256 && next(0, u)) { const int row = u.pm * 256 + tid;
#pragma unroll
            for (int q = 0; q < 4; ++q) p[q] = ssq[(size_t)q * M + row]; }
        else {
#pragma unroll
            for (int q = 0; q < 4; ++q) p[q] = 1.0f; }
    }
    __device__ __forceinline__ void after_first_stage() const { if (tid < 256) tab[tid] = __builtin_amdgcn_rsqf(((p[0] + p[1]) + (p[2] + p[3])) * (1.0f / 1024.0f) + 1e-6f); }
    __device__ __forceinline__ void a_ready(const pg8::Unit&) const {}
    __device__ __forceinline__ void done(const pg8::Unit&) const {}
};

struct EpiResFinal {
    static constexpr bool PERM = true, AFTER_DRAIN = true;
    const bf16* xb; float* ssq; const float* gfin; float* out; const XcdBarrier* bar; unsigned* lseq; bool local_mode; bool do_final;
    __device__ __forceinline__ void fused(pg8::f32x4 (&acc)[2][2][4][2], const pg8::Unit& u, int wr, int wc, int fr, int fq, LAS unsigned char* lds, int wid, int lane) const {
        LAS float* Pt = (LAS float*)lds;
        LAS float* Rt = (LAS float*)(lds + 4096);
        const int col0 = u.pn * 256 + wc * 32 + 8 * fq;
        pg8::u32x4 xr[2][4][2];
#pragma unroll
        for (int ai = 0; ai < 2; ++ai)
#pragma unroll
            for (int m = 0; m < 4; ++m) { const size_t off = (size_t)(u.pm * 256 + ai * 128 + wr * 64 + m * 16 + fr) * 1024 + col0;
#pragma unroll
                for (int bj = 0; bj < 2; ++bj) xr[ai][m][bj] = *(const pg8::u32x4*)(xb + off + bj * 128); }
#pragma unroll
        for (int ai = 0; ai < 2; ++ai)
#pragma unroll
            for (int m = 0; m < 4; ++m) { const int rl = ai * 128 + wr * 64 + m * 16 + fr; float s = 0.f;
#pragma unroll
                for (int bj = 0; bj < 2; ++bj) { pg8::f32x4 x0, x1; pg8::unpack8f(xr[ai][m][bj], x0, x1);
                    const pg8::f32x4 v0 = acc[ai][bj][m][0] + x0, v1 = acc[ai][bj][m][1] + x1;
                    acc[ai][bj][m][0] = v0; acc[ai][bj][m][1] = v1;
                    s += (v0[0] * v0[0] + v0[1] * v0[1]) + (v0[2] * v0[2] + v0[3] * v0[3]) + (v1[0] * v1[0] + v1[1] * v1[1]) + (v1[2] * v1[2] + v1[3] * v1[3]); }
                s += __shfl_xor(s, 16); s += __shfl_xor(s, 32);
                if (fq == 0) Pt[rl * 4 + wc] = s; }
        LDS_WAIT(); __syncthreads();
        const int t = wid * 64 + lane;
        if (t < 256) { const pg8::f32x4 p = *(const LAS pg8::f32x4*)(Pt + t * 4); ssq[(size_t)u.pn * M + u.pm * 256 + t] = (p[0] + p[1]) + (p[2] + p[3]); }
        if (!do_final) return;
        if (local_mode) xcc_local_barrier(*bar, *lseq); else xcd_barrier(*bar);
        if (t < 256) { const int row = u.pm * 256 + t;
            const float sq = (ssq[row] + ssq[(size_t)M + row]) + (ssq[(size_t)2 * M + row] + ssq[(size_t)3 * M + row]);
            Rt[t] = 1.0f / sqrtf(sq * (1.0f / D) + 1e-6f); }
        pg8::f32x4 gv[2][2];
#pragma unroll
        for (int bj = 0; bj < 2; ++bj) { gv[bj][0] = *(const GAS pg8::f32x4*)(gfin + col0 + bj * 128); gv[bj][1] = *(const GAS pg8::f32x4*)(gfin + col0 + bj * 128 + 4); }
        LDS_WAIT(); __syncthreads();
#pragma unroll
        for (int ai = 0; ai < 2; ++ai)
#pragma unroll
            for (int m = 0; m < 4; ++m) { const int rl = ai * 128 + wr * 64 + m * 16 + fr; const float rs = Rt[rl];
                float* orow = out + (size_t)(u.pm * 256 + rl) * 1024 + col0;
#pragma unroll
                for (int bj = 0; bj < 2; ++bj) {
                    __builtin_nontemporal_store(acc[ai][bj][m][0] * rs * gv[bj][0], (GAS pg8::f32x4*)(orow + bj * 128));
                    __builtin_nontemporal_store(acc[ai][bj][m][1] * rs * gv[bj][1], (GAS pg8::f32x4*)(orow + bj * 128 + 4)); } }
    }
};

#ifndef ATTN_SIMPLE
#define ATTN_SIMPLE 0
#endif
#ifndef DUP_G1
#define DUP_G1 0
#endif
#ifndef DUP_G3
#define DUP_G3 0
#endif
#ifndef DUP_P0
#define DUP_P0 0
#endif
#ifndef DUP_BAR
#define DUP_BAR 0
#endif
#ifndef NO_LOCAL
#define NO_LOCAL 0
#endif
#ifndef DUP_ATT
#define DUP_ATT 0
#endif
#ifndef DUP_CONV
#define DUP_CONV 0
#endif
constexpr int NPHASE = 2 + 6 * DEPTH;
struct Args { const float* in[13]; float* out; unsigned char* ws; int ph_lo, ph_hi; };
__global__ void __launch_bounds__(NWAVES * 64, 2) mk_fwd(Args args) {
    extern __shared__ __attribute__((aligned(16))) unsigned char lds[];
    Frame F;
    F.lds = (LAS unsigned char*)lds;
    F.MISC = (volatile LAS unsigned*)(F.lds + MISC_OFF);
    F.tid = threadIdx.x; F.lane = F.tid & 63; F.wave = __builtin_amdgcn_readfirstlane(F.tid >> 6);
    F.G = gridDim.x; { const int bx = blockIdx.x; F.vcu = (F.G % 8 == 0) ? (bx % 8) * (F.G / 8) + bx / 8 : bx; }
    unsigned char* ws = args.ws;
    F.ctl = (gu32*)(ws + WS_CTL);
    Ptrs P;
    P.x = args.in[0]; P.mix_norm = args.in[1]; P.ffn_norm = args.in[2]; P.final_norm = args.in[3]; P.conv_w_in = args.in[4]; P.conv_kernel = args.in[5]; P.conv_w_out = args.in[6];
    P.attn_w_qkv = args.in[7]; P.attn_w_out = args.in[8]; P.rel_bias = args.in[9]; P.w_gate = args.in[10]; P.w_up = args.in[11]; P.w_down = args.in[12]; P.out = args.out; P.ws = ws;
    for (int u = F.tid; u < (LDS_BYTES - LDSCTL_OFF) / 4; u += NWAVES * 64) ((LAS unsigned*)(F.lds + LDSCTL_OFF))[u] = 0u;
    __syncthreads();
    XcdBarrier bar = xcd_barrier_post((unsigned*)(F.ctl + CW_BAR), F.MISC + 8);
    int cid = (int)blockIdx.x;
    bool local_mode = false; unsigned lseq = 0u;
    bf16* XB = (bf16*)(ws + WS_XB); float* SSQ = (float*)(ws + WS_SSQ); bf16* ACT = (bf16*)(ws + WS_ACT); bf16* MIX = (bf16*)(ws + WS_MIX);
    const int lo = args.ph_lo, hi = args.ph_hi;
#define IN(k) (lo <= (k) && (k) < hi)
#if DUP_G1
#define REPG1(...) { __VA_ARGS__ __VA_ARGS__ }
#else
#define REPG1(...) __VA_ARGS__
#endif
#if DUP_G3
#define REPG3(...) { __VA_ARGS__ __VA_ARGS__ }
#else
#define REPG3(...) __VA_ARGS__
#endif
#if DUP_ATT
#define REPATT(...) { __VA_ARGS__ __syncthreads(); __VA_ARGS__ }
#else
#define REPATT(...) __VA_ARGS__
#endif
#if DUP_CONV
#define REPCONV(...) { __VA_ARGS__ __syncthreads(); __VA_ARGS__ }
#else
#define REPCONV(...) __VA_ARGS__
#endif
#define SEAMG(k) do { if (IN(k) && IN((k) + 1)) { xcd_barrier(bar); if (DUP_BAR) xcd_barrier(bar); } } while (0)
#define SEAM(k) do { if (IN(k) && IN((k) + 1)) { if (local_mode) xcc_local_barrier(bar, lseq); else xcd_barrier(bar); if (DUP_BAR) { if (local_mode) xcc_local_barrier(bar, lseq); else xcd_barrier(bar); } } } while (0)
    if (IN(0)) { p0_prologue(F, P); if (DUP_P0) { __syncthreads(); p0_prologue(F, P); } } SEAMG(0);
    if (lo == 0 && hi == NPHASE && F.G == 256 && !NO_LOCAL) {
        if (F.tid == 0) { unsigned ok = 1u;
#pragma unroll
            for (unsigned jx = 0; jx < 16; ++jx) { const unsigned cx = xb_ld(&bar.bar[XB_XCNT(jx)]); ok &= (cx == (jx < 8u ? 32u : 0u)) ? 1u : 0u; }
            F.MISC[11] = ok; }
        __syncthreads();
        local_mode = F.MISC[11] != 0u;
        if (local_mode) { const int rank = (int)F.MISC[10], xcc = (int)bar.x; cid = rank * 8 + xcc; F.vcu = xcc * 32 + rank; }
    }
#define LAYER(li) do { \
        constexpr int j = (li) >> 1; constexpr bool is_attn = ((li) & 1) != 0; constexpr int p0 = 1 + 6 * (li); \
        const unsigned char* wl = ws + WS_W + (size_t)(li) * W_LAYER; \
        if (IN(p0)) REPG1({ pg8::Gemm g{XB, (const bf16*)(wl + W_IN_OFF), M, 3072, 1024}; RstdOrder S; S.init(M, 3072, F.G, cid); S.load(F, SSQ); \
            if (is_attn) { pg8::EpiQKV E{ACT, (const LAS float*)(F.lds + RSTD_OFF), C2, F.lds + XPOSE_OFF}; pg8::gemm_phase<pg8::EpiQKV, RstdOrder, true, true>(F.lds + RING_OFF, g, S, E); } \
            else { pg8::EpiConvIn E{ACT, ACT + (size_t)M * 1024, (const LAS float*)(F.lds + RSTD_OFF), F.lds + XPOSE_OFF}; pg8::gemm_phase<pg8::EpiConvIn, RstdOrder, true, true>(F.lds + RING_OFF, g, S, E); } }) \
        SEAM(p0); \
        if (IN(p0 + 1)) { if (is_attn) REPATT({ if (ATTN_SIMPLE) attn_simple(F, ACT, P.rel_bias, MIX); else att::attn_phase<0>(F, ACT, P.rel_bias, MIX, (bf16*)P.out, (float*)((char*)P.out + 32 * MiB)); }) \
                          else REPCONV({ conv_pass(F, ACT, ACT + (size_t)M * 1024, P.conv_kernel + (size_t)j * 3 * 1024, MIX); }) } \
        SEAM(p0 + 1); \
        if (is_attn && !ATTN_SIMPLE) { if (IN(p0 + 2)) att::attn_phase<1>(F, ACT, P.rel_bias, MIX, (bf16*)P.out, (float*)((char*)P.out + 32 * MiB)); SEAM(p0 + 2); } \
        if (IN(p0 + 3)) { pg8::Gemm g{MIX, (const bf16*)(wl + W_OUT_OFF), M, 1024, 1024}; pg8::StaticOrder S; S.init(M, 1024, F.G, cid); \
            pg8::EpiRes E{XB, SSQ}; pg8::gemm_phase<pg8::EpiRes, pg8::StaticOrder, false, true>(F.lds + RING_OFF, g, S, E); } \
        SEAM(p0 + 3); \
        if (IN(p0 + 4)) { if ((li) + 1 < DEPTH && cid >= 128) { convert_layer_weights(F, P, (li) + 1, (cid - 128) * NWAVES + F.wave, 128 * NWAVES, 1); __syncthreads(); } } \
        if (IN(p0 + 4)) REPG3({ pg8::Gemm g{XB, (const bf16*)(wl + W_GU_OFF), M, 5632, 1024}; RstdOrder S; S.init(M, 5632, F.G, cid); if ((li) + 1 == DEPTH && F.G == 256) S.cap = 5; S.load(F, SSQ); \
            pg8::EpiSwiGLU E{ACT, (const LAS float*)(F.lds + RSTD_OFF), F.lds + XPOSE_OFF}; pg8::gemm_phase<pg8::EpiSwiGLU, RstdOrder, true, true>(F.lds + RING_OFF, g, S, E); \
            if ((li) + 1 == DEPTH && F.G == 256) { HalfOrder H; H.init(F.G, cid); H.load(F, SSQ); \
                pg8::EpiSwiGLUHalf E2{ACT, (const LAS float*)(F.lds + RSTD_OFF), F.lds + XPOSE_OFF}; pg8::gemm_phase<pg8::EpiSwiGLUHalf, HalfOrder, true, true, true>(F.lds + RING_OFF, g, H, E2); } }) \
        if (IN(p0 + 4)) { if ((li) + 1 < DEPTH && cid >= 128) { __syncthreads(); convert_layer_weights(F, P, (li) + 1, (cid - 128) * NWAVES + F.wave, 128 * NWAVES, 2); } } \
        SEAM(p0 + 4); \
        if (IN(p0 + 5)) { pg8::Gemm g{ACT, (const bf16*)(wl + W_DN_OFF), M, 1024, 2816}; pg8::StaticOrder S; S.init(M, 1024, F.G, cid); \
            if ((li) + 1 < DEPTH) { pg8::EpiRes E{XB, SSQ}; pg8::gemm_phase<pg8::EpiRes, pg8::StaticOrder, false, true>(F.lds + RING_OFF, g, S, E); } \
            else { EpiResFinal E{XB, SSQ, P.final_norm, P.out, &bar, &lseq, local_mode, IN(NPHASE - 1)}; pg8::gemm_phase<EpiResFinal, pg8::StaticOrder, false, true>(F.lds + RING_OFF, g, S, E); } } \
        if ((li) + 1 < DEPTH) SEAMG(p0 + 5); \
    } while (0)
    LAYER(0); LAYER(1); LAYER(2); LAYER(3);
}

#ifndef MK_PER_PHASE
#define MK_PER_PHASE 0
#endif
extern "C" void kernel_launch(void* const* d_in, const int* in_sizes, int n_in, void* d_out, int out_size, void* d_ws, size_t ws_size, hipStream_t stream) {
    static int grid = 0;
    if (grid == 0) {
        if (n_in != 13 || in_sizes[0] != M * D || out_size != M * D || ws_size < WS_END) { fprintf(stderr, "kernel_launch: unexpected shapes (n_in %d, in0 %d, out %d, ws %zu)\n", n_in, n_in > 0 ? in_sizes[0] : -1, out_size, ws_size); grid = -1; return; }
        int dev = 0, cus = 0, per_cu = 0;
        if (hipGetDevice(&dev) != hipSuccess || hipDeviceGetAttribute(&cus, hipDeviceAttributeMultiprocessorCount, dev) != hipSuccess) { grid = -1; return; }
        if (hipFuncSetAttribute((const void*)mk_fwd, hipFuncAttributeMaxDynamicSharedMemorySize, LDS_BYTES) != hipSuccess) { fprintf(stderr, "kernel_launch: hipFuncSetAttribute failed\n"); grid = -1; return; }
        if (hipOccupancyMaxActiveBlocksPerMultiprocessor(&per_cu, (const void*)mk_fwd, NWAVES * 64, LDS_BYTES) != hipSuccess || per_cu < 1) { fprintf(stderr, "kernel_launch: occupancy query says %d blocks per CU\n", per_cu); (void)hipGetLastError(); grid = -1; return; }
        grid = cus;
        if (grid != 256) fprintf(stderr, "kernel_launch: %d CUs; this kernel is laid out for 256\n", grid);
    }
    if (grid < 0) return;
    (void)hipMemsetAsync((char*)d_ws + WS_CTL, 0, CTL_ZERO_BYTES, stream);
    Args a{};
    for (int i = 0; i < 13; ++i) a.in[i] = (const float*)d_in[i];
    a.out = (float*)d_out; a.ws = (unsigned char*)d_ws;
#if MK_PER_PHASE
    for (int ph = 0; ph < NPHASE; ++ph) { a.ph_lo = ph; a.ph_hi = ph + 1; hipLaunchKernelGGL(mk_fwd, dim3(grid), dim3(NWAVES * 64), LDS_BYTES, stream, a); }
#else
    a.ph_lo = 0; a.ph_hi = NPHASE;
    hipLaunchKernelGGL(mk_fwd, dim3(grid), dim3(NWAVES * 64), LDS_BYTES, stream, a);
#endif
}
```

```cpp
#include <hip/hip_runtime.h>
#include <cstdio>
#include <cstdint>
namespace pg8 {
#define PG8_LAS __attribute__((address_space(3)))
typedef unsigned short bf16_t;
typedef short bf16x8 __attribute__((ext_vector_type(8)));
typedef float f32x4 __attribute__((ext_vector_type(4)));
typedef unsigned u32x4 __attribute__((ext_vector_type(4)));
constexpr int BM = 256, BK = 64, HALF = 128, HTB = HALF * BK * 2  , STAGE_BYTES = 8 * HTB, NXCD = 8, WGM = 4;

__host__ __device__ __forceinline__ int lds_byte(int r, int c) { const int st = (r >> 4) * 2 + (c >> 5), rr = r & 15, cc = c & 31, ob = rr * 64 + cc * 2; return st * 1024 + (ob ^ (((ob >> 9) & 1) << 5)); }
__host__ __device__ __forceinline__ void stage_rc(int b, int& R, int& C) { const int st = b / 1024, sb = b % 1024, swz = sb ^ (((sb >> 9) & 1) << 5); R = (st >> 1) * 16 + swz / 64; C = (st & 1) * 32 + (swz % 64) / 2; }
__host__ __device__ __forceinline__ int perm32(int rho) { const int n = rho >> 4, i = rho & 15; return 8 * (i >> 2) + 4 * n + (i & 3); }

struct Unit { int pm, pn, ord; };
struct Gemm { const bf16_t* A; const bf16_t* Bt; int M, N, K; long gapA; };

struct StaticOrder {
    int nM, nN, nwg, G, c;
    __host__ __device__ void init(int M, int N, int G_, int c_) { nM = M / BM; nN = N / BM; nwg = nM * nN; G = G_; c = c_; }
    __host__ __device__ bool next(int i, Unit& u) const {
        const long L = (long)i * G + c; if (L >= nwg) return false;
        int wgid = (int)L; { const int q = nwg / NXCD, r = nwg % NXCD, xcd = wgid % NXCD, off = wgid / NXCD; wgid = (xcd < r ? xcd * (q + 1) : r * (q + 1) + (xcd - r) * q) + off; }
        const int nig = WGM * nN, gid = wgid / nig, fm = gid * WGM, gsz = (nM - fm) < WGM ? (nM - fm) : WGM;
        u.pm = fm + ((wgid % nig) % gsz); u.pn = (wgid % nig) / gsz; u.ord = i; return true;
    }
    __device__ __forceinline__ void a_ready(const Unit&) const {}
    __device__ __forceinline__ void done(const Unit&) const {}
    __device__ __forceinline__ void after_first_stage() const {}
};

constexpr size_t SLAB_ELEMS = 6291456, SLAB_GAP_HID = SLAB_ELEMS - (size_t)2048 * 2816, SLAB_GAP_BC = SLAB_ELEMS - (size_t)2048 * 1024, SLAB_CU_OFF = (size_t)2048 * 1024;
constexpr int MROWS = 16384;
#ifndef USE_F16
#define USE_F16 0
#endif
typedef _Float16 h16x2 __attribute__((ext_vector_type(2))); typedef _Float16 h16x8 __attribute__((ext_vector_type(8))); typedef float f32x2c __attribute__((ext_vector_type(2)));
#if USE_F16
__device__ __forceinline__ unsigned cvt_pk_bf16(float lo, float hi) { const f32x2c v = {lo, hi}; return __builtin_bit_cast(unsigned, __builtin_convertvector(v, h16x2)); }
#define PG8_MFMA16(a, b, c) __builtin_amdgcn_mfma_f32_16x16x32_f16(__builtin_bit_cast(pg8::h16x8, (a)), __builtin_bit_cast(pg8::h16x8, (b)), (c), 0, 0, 0)
#else
typedef __bf16 bf16x2c __attribute__((ext_vector_type(2)));
__device__ __forceinline__ unsigned cvt_pk_bf16(float lo, float hi) { const f32x2c v = {lo, hi}; return __builtin_bit_cast(unsigned, __builtin_convertvector(v, bf16x2c)); }
#define PG8_MFMA16(a, b, c) __builtin_amdgcn_mfma_f32_16x16x32_bf16((a), (b), (c), 0, 0, 0)
#endif
__device__ __forceinline__ u32x4 pack8(const f32x4 v0, const f32x4 v1) { u32x4 w; w.x = cvt_pk_bf16(v0[0], v0[1]); w.y = cvt_pk_bf16(v0[2], v0[3]); w.z = cvt_pk_bf16(v1[0], v1[1]); w.w = cvt_pk_bf16(v1[2], v1[3]); return w; }
__device__ __forceinline__ float row_rstd(const float* ssq, int row) {
    const float s = (ssq[row] + ssq[MROWS + row]) + (ssq[2 * MROWS + row] + ssq[3 * MROWS + row]);
    return __builtin_amdgcn_rsqf(s * (1.0f / 1024.0f) + 1e-6f);
}
#define XPOSE_SETUP(stg_, wr_, wc_, fr_, fq_) const int xp_lane = (fq_) * 16 + (fr_), xp_tr = xp_lane >> 2, xp_tc = xp_lane & 3; PG8_LAS unsigned char* const xp_sl = (stg_) + ((wr_) * 4 + (wc_)) * 2048; \
    const int xp_wo = (fr_) * 64 + (((fq_) ^ ((fr_) >> 2)) << 4), xp_ro = xp_tr * 64 + ((xp_tc ^ (xp_tr >> 2)) << 4)
__device__ __forceinline__ u32x4 xpose_turn(PG8_LAS unsigned char* slot, int wo, int ro, const u32x4 v) { *(PG8_LAS u32x4*)(slot + wo) = v; return *(const PG8_LAS u32x4*)(slot + ro); }
#define XPOSE_TURN(slot_, v_) xpose_turn(xp_sl + (slot_) * 1024, xp_wo, xp_ro, (v_))
struct EpiQKV {
    static constexpr bool PERM = true, AFTER_DRAIN = false;
    bf16_t* O; const PG8_LAS float* rs; float c2; PG8_LAS unsigned char* stg;
    __device__ __forceinline__ void operator()(const f32x4 (&acc)[2][2][4][2], const Unit& u, int wr, int wc, int fr, int fq) const {
        XPOSE_SETUP(stg, wr, wc, fr, fq);
        const int row0 = u.pm * BM + wr * 64 + xp_tr, col0 = u.pn * BM + wc * 32 + 8 * xp_tc;
        const float sc = (u.pn < 4) ? c2 : 1.0f;
#pragma unroll
        for (int ai = 0; ai < 2; ++ai)
#pragma unroll
            for (int m = 0; m < 4; ++m) { const int row = row0 + ai * HALF + m * 16; const float rs = this->rs[u.ord * BM + ai * HALF + wr * 64 + m * 16 + fr] * sc; bf16_t* rowp = O + (size_t)row * 3072 + col0;
#pragma unroll
                for (int bj = 0; bj < 2; ++bj) *(u32x4*)(rowp + bj * HALF) = XPOSE_TURN(bj, pack8(acc[ai][bj][m][0] * rs, acc[ai][bj][m][1] * rs)); }
    }
};
struct EpiConvIn {
    static constexpr bool PERM = true, AFTER_DRAIN = false;
    bf16_t* Bo; bf16_t* CU; const PG8_LAS float* rs; PG8_LAS unsigned char* stg;
    __device__ __forceinline__ void operator()(const f32x4 (&acc)[2][2][4][2], const Unit& u, int wr, int wc, int fr, int fq) const {
        XPOSE_SETUP(stg, wr, wc, fr, fq);
        const int row0 = u.pm * BM + wr * 64 + xp_tr;
        if (u.pn < 4) {
            const int col0 = u.pn * BM + wc * 32 + 8 * xp_tc;
#pragma unroll
            for (int ai = 0; ai < 2; ++ai)
#pragma unroll
                for (int m = 0; m < 4; ++m) { const int row = row0 + ai * HALF + m * 16; const float rs = this->rs[u.ord * BM + ai * HALF + wr * 64 + m * 16 + fr]; bf16_t* rowp = Bo + (size_t)row * 1024 + (size_t)(row >> 11) * SLAB_GAP_BC + col0;
#pragma unroll
                    for (int bj = 0; bj < 2; ++bj) *(u32x4*)(rowp + bj * HALF) = XPOSE_TURN(bj, pack8(acc[ai][bj][m][0] * rs, acc[ai][bj][m][1] * rs)); }
        } else {
            const int col0 = (u.pn - 4) * HALF + wc * 32 + 8 * xp_tc;
#pragma unroll
            for (int ai = 0; ai < 2; ++ai)
#pragma unroll
                for (int m = 0; m < 4; ++m) { const int row = row0 + ai * HALF + m * 16; const float rs = this->rs[u.ord * BM + ai * HALF + wr * 64 + m * 16 + fr]; const float rs2 = rs * rs;
                    *(u32x4*)(CU + (size_t)row * 1024 + (size_t)(row >> 11) * SLAB_GAP_BC + col0) = XPOSE_TURN(m & 1, pack8(acc[ai][0][m][0] * acc[ai][1][m][0] * rs2, acc[ai][0][m][1] * acc[ai][1][m][1] * rs2)); }
        }
    }
};
__device__ __forceinline__ f32x4 swiglu4(const f32x4 g, const f32x4 u, float rs) {
    const f32x4 gk = g * (rs * -1.4426950408889634f);
    f32x4 t; t[0] = __builtin_amdgcn_exp2f(gk[0]); t[1] = __builtin_amdgcn_exp2f(gk[1]); t[2] = __builtin_amdgcn_exp2f(gk[2]); t[3] = __builtin_amdgcn_exp2f(gk[3]);
    const f32x4 d = t + 1.0f;
    f32x4 r; r[0] = __builtin_amdgcn_rcpf(d[0]); r[1] = __builtin_amdgcn_rcpf(d[1]); r[2] = __builtin_amdgcn_rcpf(d[2]); r[3] = __builtin_amdgcn_rcpf(d[3]);
    return (g * u) * (r * (rs * rs));
}
struct EpiSwiGLU {
    static constexpr bool PERM = true, AFTER_DRAIN = false;
    bf16_t* Hd; const PG8_LAS float* rs; PG8_LAS unsigned char* stg;
    __device__ __forceinline__ void operator()(const f32x4 (&acc)[2][2][4][2], const Unit& u, int wr, int wc, int fr, int fq) const {
        XPOSE_SETUP(stg, wr, wc, fr, fq);
        const int row0 = u.pm * BM + wr * 64 + xp_tr, col0 = u.pn * HALF + wc * 32 + 8 * xp_tc;
#pragma unroll
        for (int ai = 0; ai < 2; ++ai)
#pragma unroll
            for (int m = 0; m < 4; ++m) { const int row = row0 + ai * HALF + m * 16; const float rs = this->rs[u.ord * BM + ai * HALF + wr * 64 + m * 16 + fr];
                *(u32x4*)(Hd + (size_t)row * 2816 + (size_t)(row >> 11) * SLAB_GAP_HID + col0) = XPOSE_TURN(m & 1, pack8(swiglu4(acc[ai][0][m][0], acc[ai][1][m][0], rs), swiglu4(acc[ai][0][m][1], acc[ai][1][m][1], rs))); }
    }
};
__device__ __forceinline__ void unpack8f(const u32x4 w, f32x4& a, f32x4& b) {
#if USE_F16
    const unsigned w0 = w.x, w1 = w.y, w2 = w.z, w3 = w.w;
    const f32x2c p0 = __builtin_convertvector(__builtin_bit_cast(h16x2, w0), f32x2c), p1 = __builtin_convertvector(__builtin_bit_cast(h16x2, w1), f32x2c);
    const f32x2c p2 = __builtin_convertvector(__builtin_bit_cast(h16x2, w2), f32x2c), p3 = __builtin_convertvector(__builtin_bit_cast(h16x2, w3), f32x2c);
    a[0] = p0.x; a[1] = p0.y; a[2] = p1.x; a[3] = p1.y; b[0] = p2.x; b[1] = p2.y; b[2] = p3.x; b[3] = p3.y;
#else
    a[0] = __builtin_bit_cast(float, w.x << 16); a[1] = __builtin_bit_cast(float, w.x & 0xffff0000u); a[2] = __builtin_bit_cast(float, w.y << 16); a[3] = __builtin_bit_cast(float, w.y & 0xffff0000u);
    b[0] = __builtin_bit_cast(float, w.z << 16); b[1] = __builtin_bit_cast(float, w.z & 0xffff0000u); b[2] = __builtin_bit_cast(float, w.w << 16); b[3] = __builtin_bit_cast(float, w.w & 0xffff0000u);
#endif
}
struct EpiRes {
    static constexpr bool PERM = true, AFTER_DRAIN = true;
    bf16_t* xb; float* ssq;
    __device__ __forceinline__ void fused(f32x4 (&acc)[2][2][4][2], const Unit& u, int wr, int wc, int fr, int fq, PG8_LAS unsigned char* lds, int wid, int lane) const {
        PG8_LAS float* P = (PG8_LAS float*)lds;
        const int col0 = u.pn * BM + wc * 32 + 8 * fq;
        u32x4 xr[2][4][2];
#pragma unroll
        for (int ai = 0; ai < 2; ++ai)
#pragma unroll
            for (int m = 0; m < 4; ++m) { const size_t off = (size_t)(u.pm * BM + ai * HALF + wr * 64 + m * 16 + fr) * 1024 + col0;
#pragma unroll
                for (int bj = 0; bj < 2; ++bj) xr[ai][m][bj] = *(const u32x4*)(xb + off + bj * HALF); }
#pragma unroll
        for (int ai = 0; ai < 2; ++ai)
#pragma unroll
            for (int m = 0; m < 4; ++m) { const int rl = ai * HALF + wr * 64 + m * 16 + fr; const size_t off = (size_t)(u.pm * BM + rl) * 1024 + col0; float s = 0.f;
#pragma unroll
                for (int bj = 0; bj < 2; ++bj) { f32x4 x0, x1; unpack8f(xr[ai][m][bj], x0, x1);
                    const f32x4 v0 = acc[ai][bj][m][0] + x0, v1 = acc[ai][bj][m][1] + x1;
                    *(u32x4*)(xb + off + bj * HALF) = pack8(v0, v1);
                    s += (v0[0] * v0[0] + v0[1] * v0[1]) + (v0[2] * v0[2] + v0[3] * v0[3]) + (v1[0] * v1[0] + v1[1] * v1[1]) + (v1[2] * v1[2] + v1[3] * v1[3]); }
                s += __shfl_xor(s, 16); s += __shfl_xor(s, 32);
                if (fq == 0) P[rl * 4 + wc] = s; }
        asm volatile("s_waitcnt lgkmcnt(0)" ::: "memory"); __builtin_amdgcn_s_barrier(); asm volatile("" ::: "memory");
        const int t = wid * 64 + lane;
        if (t < 256) { const f32x4 p = *(const PG8_LAS f32x4*)(P + t * 4); ssq[(size_t)u.pn * MROWS + u.pm * BM + t] = (p[0] + p[1]) + (p[2] + p[3]); }
    }
};

template <class Epi, class Sched, bool ALIGN_EPI = false, bool SP2 = false>
__device__ __forceinline__ void gemm_phase(PG8_LAS unsigned char* lds, const Gemm g, const Sched& S, const Epi& E) {
    const int tid = threadIdx.x, wid = __builtin_amdgcn_readfirstlane(tid >> 6), lane = tid & 63, wr = wid >> 2, wc = wid & 3, fr = lane & 15, fq = lane >> 4;
    const int K = g.K, nt = K / BK;
    unsigned voffA[2], voffB[2];
#pragma unroll
    for (int i = 0; i < 2; ++i) { int R, C; stage_rc(tid * 16 + i * 8192, R, C); const int Rb = Epi::PERM ? ((R & ~31) + perm32(R & 31)) : R;
        voffA[i] = (unsigned)(R * K + C) * 2u; voffB[i] = (unsigned)(Rb * K + C) * 2u; }
    const size_t kstep = (size_t)(BK * 2);
    const size_t hstep = (size_t)HALF * K * 2;
    const size_t tstep = 2 * hstep;
    const unsigned ldsw = (unsigned)wid * 1024u;
    const int aoff = lds_byte(wr * 64 + fr, fq * 8), boff = lds_byte(wc * 32 + fr, fq * 8);
#define PG8_SA(b, h) (((b) * 2 + (h)) * HTB)
#define PG8_SB(b, h) ((4 + (b) * 2 + (h)) * HTB)
#define PG8_STAGE(bufoff, gbase, voff) do { _Pragma("unroll") for (int _i = 0; _i < 2; ++_i) \
        __builtin_amdgcn_global_load_lds((const unsigned*)((const char*)(gbase) + (voff)[_i]), (PG8_LAS unsigned*)(lds + (bufoff) + ldsw + _i * 8192), 16, 0, 0); } while (0)
#define PG8_LDA(dst, b, h) do { _Pragma("unroll") for (int m = 0; m < 4; ++m) _Pragma("unroll") for (int k = 0; k < 2; ++k) dst[m][k] = *(const PG8_LAS bf16x8*)(lds + PG8_SA(b, h) + aoff + m * 2048 + k * 1024); } while (0)
#define PG8_LDB(dst, b, h) do { _Pragma("unroll") for (int n = 0; n < 2; ++n) _Pragma("unroll") for (int k = 0; k < 2; ++k) dst[n][k] = *(const PG8_LAS bf16x8*)(lds + PG8_SB(b, h) + boff + n * 2048 + k * 1024); } while (0)
#define PG8_MMA(ai, bj, At, Bt) do { __builtin_amdgcn_s_setprio(1); _Pragma("unroll") for (int m = 0; m < 4; ++m) _Pragma("unroll") for (int n = 0; n < 2; ++n) _Pragma("unroll") for (int k = 0; k < 2; ++k) \
        acc[ai][bj][m][n] = PG8_MFMA16(Bt[n][k], At[m][k], acc[ai][bj][m][n]); __builtin_amdgcn_s_setprio(0); } while (0)
#define PG8_WAIT_V(n) asm volatile("s_waitcnt vmcnt(" #n ")" ::: "memory")
#define PG8_WAIT_L(n) asm volatile("s_waitcnt lgkmcnt(" #n ")" ::: "memory")
#define PG8_BAR __builtin_amdgcn_s_barrier()
#define PG8_SCHED __builtin_amdgcn_sched_barrier(0)
    Unit cur, nxt; int ui = 0;
    if (!S.next(0, cur)) return;
    f32x4 acc[2][2][4][2];
#pragma unroll
    for (int a = 0; a < 2; ++a)
#pragma unroll
        for (int b = 0; b < 2; ++b)
#pragma unroll
            for (int m = 0; m < 4; ++m)
#pragma unroll
                for (int n = 0; n < 2; ++n) acc[a][b][m][n] = (f32x4){0.f, 0.f, 0.f, 0.f};
    bf16x8 At[4][2], B0[2][2], B1[2][2];
    const char* cA = (const char*)g.A + (size_t)cur.pm * tstep + (size_t)(cur.pm >> 3) * (size_t)g.gapA; const char* cB = (const char*)g.Bt + (size_t)cur.pn * tstep;
    S.a_ready(cur);
    if constexpr (SP2) {
        PG8_STAGE(PG8_SB(0, 0), cB, voffB); PG8_STAGE(PG8_SB(0, 1), cB + hstep, voffB); PG8_STAGE(PG8_SA(0, 0), cA, voffA); PG8_STAGE(PG8_SA(0, 1), cA + hstep, voffA);
        S.after_first_stage();
        if (wr == 1) PG8_BAR;
        PG8_WAIT_V(2); PG8_BAR;
        PG8_STAGE(PG8_SB(1, 0), cB + kstep, voffB); PG8_STAGE(PG8_SA(1, 0), cA + kstep, voffA); PG8_STAGE(PG8_SB(1, 1), cB + hstep + kstep, voffB);
        PG8_WAIT_V(6); PG8_BAR;
    } else {
        PG8_STAGE(PG8_SB(0, 0), cB, voffB); PG8_STAGE(PG8_SA(0, 0), cA, voffA); PG8_STAGE(PG8_SB(0, 1), cB + hstep, voffB); PG8_STAGE(PG8_SA(0, 1), cA + hstep, voffA);
        if (wr == 1) PG8_BAR;
        PG8_WAIT_V(4); PG8_BAR;
        PG8_STAGE(PG8_SB(1, 0), cB + kstep, voffB); PG8_STAGE(PG8_SA(1, 0), cA + kstep, voffA); PG8_STAGE(PG8_SB(1, 1), cB + hstep + kstep, voffB);
        PG8_WAIT_V(6); PG8_BAR;
    }
    for (;;) {
        const bool has_next = S.next(ui + 1, nxt);
        const char* nA = has_next ? (const char*)g.A + (size_t)nxt.pm * tstep + (size_t)(nxt.pm >> 3) * (size_t)g.gapA : cA; const char* nB = has_next ? (const char*)g.Bt + (size_t)nxt.pn * tstep : cB;
        for (int t = 0; t < nt; t += 2) {
            const bool last = (t == nt - 2);
            const char* a1 = cA + (size_t)(t + 1) * kstep;
            const char* a2 = last ? nA : cA + (size_t)(t + 2) * kstep; const char* b2 = last ? nB : cB + (size_t)(t + 2) * kstep;
            const char* a3 = a2 + kstep; const char* b3 = b2 + kstep;
            if (last && has_next) S.a_ready(nxt);
            if constexpr (SP2) {
            PG8_LDB(B0, 0, 0); PG8_LDB(B1, 0, 1); PG8_SCHED; PG8_LDA(At, 0, 0); PG8_STAGE(PG8_SA(1, 1), a1 + hstep, voffA);
            PG8_WAIT_V(8); PG8_WAIT_L(0); PG8_BAR; PG8_MMA(0, 0, At, B0); PG8_MMA(0, 1, At, B1); PG8_BAR; PG8_SCHED;
            PG8_LDA(At, 0, 1); PG8_STAGE(PG8_SB(0, 0), b2, voffB); PG8_STAGE(PG8_SB(0, 1), b2 + hstep, voffB); PG8_STAGE(PG8_SA(0, 0), a2, voffA);
            PG8_WAIT_V(8); PG8_WAIT_L(0); PG8_BAR; PG8_MMA(1, 0, At, B0); PG8_MMA(1, 1, At, B1); PG8_BAR; PG8_SCHED;
            PG8_LDB(B0, 1, 0); PG8_LDB(B1, 1, 1); PG8_SCHED; PG8_LDA(At, 1, 0); PG8_STAGE(PG8_SA(0, 1), a2 + hstep, voffA);
            PG8_WAIT_V(8); PG8_WAIT_L(0); PG8_BAR; PG8_MMA(0, 0, At, B0); PG8_MMA(0, 1, At, B1); PG8_BAR; PG8_SCHED;
            PG8_LDA(At, 1, 1); PG8_STAGE(PG8_SB(1, 0), b3, voffB); PG8_STAGE(PG8_SB(1, 1), b3 + hstep, voffB); PG8_STAGE(PG8_SA(1, 0), a3, voffA);
            PG8_WAIT_V(8); PG8_WAIT_L(0); PG8_BAR; PG8_MMA(1, 0, At, B0); PG8_MMA(1, 1, At, B1); PG8_BAR; PG8_SCHED;
            } else {
            PG8_LDB(B0, 0, 0); PG8_SCHED; PG8_LDA(At, 0, 0); PG8_STAGE(PG8_SA(1, 1), a1 + hstep, voffA);
            PG8_WAIT_L(8); PG8_BAR; PG8_WAIT_L(0); PG8_MMA(0, 0, At, B0); PG8_BAR; PG8_SCHED;
            PG8_LDB(B1, 0, 1); PG8_STAGE(PG8_SB(0, 0), b2, voffB);
            PG8_BAR; PG8_WAIT_L(0); PG8_MMA(0, 1, At, B1); PG8_BAR;
            PG8_LDA(At, 0, 1); PG8_STAGE(PG8_SA(0, 0), a2, voffA);
            PG8_BAR; PG8_WAIT_L(0); PG8_MMA(1, 0, At, B0); PG8_BAR; PG8_SCHED;
            PG8_STAGE(PG8_SB(0, 1), b2 + hstep, voffB);
            PG8_WAIT_V(6); PG8_BAR; PG8_MMA(1, 1, At, B1); PG8_BAR;
            PG8_LDB(B0, 1, 0); PG8_SCHED; PG8_LDA(At, 1, 0); PG8_STAGE(PG8_SA(0, 1), a2 + hstep, voffA);
            PG8_WAIT_L(8); PG8_BAR; PG8_WAIT_L(0); PG8_MMA(0, 0, At, B0); PG8_BAR; PG8_SCHED;
            PG8_LDB(B1, 1, 1); PG8_STAGE(PG8_SB(1, 0), b3, voffB);
            PG8_BAR; PG8_WAIT_L(0); PG8_MMA(0, 1, At, B1); PG8_BAR;
            PG8_LDA(At, 1, 1); PG8_STAGE(PG8_SA(1, 0), a3, voffA);
            PG8_BAR; PG8_WAIT_L(0); PG8_MMA(1, 0, At, B0); PG8_BAR; PG8_SCHED;
            PG8_STAGE(PG8_SB(1, 1), b3 + hstep, voffB);
            PG8_WAIT_V(6); PG8_BAR; PG8_MMA(1, 1, At, B1); PG8_BAR;
            }
        }
        if constexpr (ALIGN_EPI) { if (wr == 0) PG8_BAR; }
        if constexpr (!Epi::AFTER_DRAIN) { E(acc, cur, wr, wc, fr, fq);
#if defined(DUP_EPI)
            asm volatile("" ::: "memory"); E(acc, cur, wr, wc, fr, fq);
#endif
            S.done(cur); }
        if (!has_next) break;
#pragma unroll
        for (int a = 0; a < 2; ++a)
#pragma unroll
            for (int b = 0; b < 2; ++b)
#pragma unroll
                for (int m = 0; m < 4; ++m)
#pragma unroll
                    for (int n = 0; n < 2; ++n) acc[a][b][m][n] = (f32x4){0.f, 0.f, 0.f, 0.f};
        cur = nxt; cA = nA; cB = nB; ++ui;
        if constexpr (ALIGN_EPI) { if (wr == 1) PG8_BAR; }
    }
    PG8_WAIT_V(0);
    if constexpr (!ALIGN_EPI) { if (wr == 0) PG8_BAR; }
    PG8_BAR;
    if constexpr (Epi::AFTER_DRAIN) { E.fused(acc, cur, wr, wc, fr, fq, lds, wid, lane); S.done(cur); }
#undef PG8_SA
#undef PG8_SB
#undef PG8_STAGE
#undef PG8_LDA
#undef PG8_LDB
#undef PG8_MMA
#undef PG8_WAIT_V
#undef PG8_WAIT_L
#undef PG8_BAR
#undef PG8_SCHED
}
}

constexpr int NWAVES = 8;
constexpr int BATCH = 8, SEQ = 2048, D = 1024, DEPTH = 4, NH = 16, HD = 64, FF = 2816, NB = 32;
constexpr int M = BATCH * SEQ;
constexpr float C2 = 0.125f * 1.4426950408889634f;
constexpr float LOG2E = 1.4426950408889634f;

constexpr size_t MiB = 1u << 20;
constexpr size_t WS_CTL = 0, CTL_ZERO_BYTES = 64 * 1024;
constexpr size_t WS_SSQ = 1 * MiB;
constexpr size_t WS_W = 2 * MiB;
constexpr size_t W_IN_OFF = 0, W_OUT_OFF = (size_t)3072 * 1024 * 2, W_GU_OFF = W_OUT_OFF + (size_t)1024 * 1024 * 2, W_DN_OFF = W_GU_OFF + (size_t)5632 * 1024 * 2;
constexpr size_t W_LAYER = W_DN_OFF + (size_t)1024 * 2816 * 2;
constexpr size_t WS_XB = 100 * MiB;
constexpr size_t WS_ACT = 132 * MiB;
constexpr size_t WS_MIX = 228 * MiB;
constexpr size_t WS_END = 260 * MiB;
static_assert(WS_W + 4 * W_LAYER <= WS_XB && WS_MIX + (size_t)M * D * 2 <= WS_END, "d_ws map");
constexpr int CW_TMO = 0;
constexpr int CW_BAR = 1024;

constexpr int RING_OFF = 0, RING_BYTES = 131072;
constexpr int LDS_BYTES = 163840;
constexpr int LDSCTL_OFF = LDS_BYTES - 1024, MISC_OFF = LDSCTL_OFF + 320;

#define GAS __attribute__((address_space(1)))
#define LAS __attribute__((address_space(3)))
typedef unsigned short bf16;
typedef unsigned v4u __attribute__((ext_vector_type(4)));
typedef float f32x4 __attribute__((ext_vector_type(4)));
typedef GAS unsigned gu32;
#define RLX_AGENT __ATOMIC_RELAXED, __HIP_MEMORY_SCOPE_AGENT
#define LDS_WAIT() asm volatile("s_waitcnt lgkmcnt(0)" ::: "memory")
#define VM_WAIT() asm volatile("s_waitcnt vmcnt(0)" ::: "memory")
#if USE_F16
__device__ __forceinline__ unsigned f2bf(float f) { return (unsigned)__builtin_bit_cast(unsigned short, (_Float16)f); }
__device__ __forceinline__ unsigned pk2(float lo, float hi) { return pg8::cvt_pk_bf16(lo, hi); }
__device__ __forceinline__ float bf2f(unsigned short b) { return (float)__builtin_bit_cast(_Float16, b); }
#else
__device__ __forceinline__ unsigned f2bf(float f) { unsigned u = __builtin_bit_cast(unsigned, f); return (u + 0x7fffu + ((u >> 16) & 1u)) >> 16; }
__device__ __forceinline__ unsigned pk2(float lo, float hi) { return pg8::cvt_pk_bf16(lo, hi); }
__device__ __forceinline__ float bf2f(unsigned short b) { return __builtin_bit_cast(float, (unsigned)b << 16); }
#endif

#define XB_TMO      128
#define XB_XCNT(j)  (256  + 64 * (j))
#define XB_XSUB(j)  (1280 + 64 * (j))
#define XB_XGEN(j)  (2304 + 64 * (j))
#define XB_TOP      3328
#define XB_TOPGEN   3392
#define XCD_BAR_WORDS 3456
#define XB_SPIN_CAP (1u << 18)
__device__ __forceinline__ unsigned xb_ld(unsigned* p)              { return __hip_atomic_load(p, __ATOMIC_RELAXED, __HIP_MEMORY_SCOPE_AGENT); }
__device__ __forceinline__ unsigned xb_add(unsigned* p, unsigned v) { return __hip_atomic_fetch_add(p, v, __ATOMIC_RELAXED, __HIP_MEMORY_SCOPE_AGENT); }
__device__ __forceinline__ unsigned xb_xcc_id() { return (unsigned)__builtin_amdgcn_s_getreg((3 << 11) | 20) & 0xFu; }
#define XB_SPIN(cond, bar) do { unsigned _sp = 0; while (cond) { __builtin_amdgcn_s_sleep(1); \
    if ((++_sp & 255u) == 0u) { if (xb_ld(&(bar)[XB_TMO])) break; if (_sp > XB_SPIN_CAP) { atomicAdd(&(bar)[XB_TMO], 1u); break; } } } } while (0)
struct XcdBarrier { unsigned* bar; unsigned x; volatile LAS unsigned* st; };
#define XB_LOC(j)   (3520 + 64 * (j))
__device__ __forceinline__ XcdBarrier xcd_barrier_post(unsigned* bar, volatile LAS unsigned* st) {
    XcdBarrier b; b.bar = bar; b.x = xb_xcc_id(); b.st = st;
    if (threadIdx.x == 0) st[2] = xb_add(&bar[XB_XCNT(b.x)], 1u);
    return b;
}
__device__ __forceinline__ void xcc_local_barrier(const XcdBarrier& b, unsigned& seq) {
    asm volatile("s_waitcnt vmcnt(0)" ::: "memory");
    __syncthreads();
    if (threadIdx.x == 0) {
        unsigned* bar = b.bar;
        __builtin_amdgcn_s_waitcnt(0);
        __builtin_amdgcn_fence(__ATOMIC_ACQUIRE, "agent");
        xb_add(&bar[XB_LOC(b.x)], 1u);
        const unsigned target = 32u * (seq + 1u);
        XB_SPIN(xb_ld(&bar[XB_LOC(b.x)]) < target, bar);
        asm volatile("s_waitcnt vmcnt(0)" ::: "memory");
    }
    __syncthreads();
    ++seq;
}
__device__ __forceinline__ void xcd_barrier_complete(unsigned* bar, unsigned x, unsigned& nloc, unsigned& nx) {
    const unsigned G = gridDim.x * gridDim.y * gridDim.z;
    unsigned sum, cnt, mine, sp = 0u;
    for (;;) {
        sum = 0u; cnt = 0u; mine = 0u;
#pragma unroll
        for (unsigned j = 0; j < 16; ++j) { const unsigned c = xb_ld(&bar[XB_XCNT(j)]); sum += c; cnt += (c > 0u) ? 1u : 0u; mine = (j == x) ? c : mine; }
        if (sum == G) break;
        __builtin_amdgcn_s_sleep(1);
        if ((++sp & 255u) == 0u) { if (xb_ld(&bar[XB_TMO])) break; if (sp > XB_SPIN_CAP) { atomicAdd(&bar[XB_TMO], 1u); break; } }
    }
    nloc = mine > 0u ? mine : 1u; nx = cnt > 0u ? cnt : 1u;
}
__device__ __forceinline__ void xcd_barrier(const XcdBarrier& b) {
    asm volatile("s_waitcnt vmcnt(0)" ::: "memory");
    __syncthreads();
    if (threadIdx.x == 0) {
        unsigned* bar = b.bar;
        __builtin_amdgcn_s_waitcnt(0);
        unsigned nloc = b.st[0], nx = b.st[1];
        if (nloc == 0u) { xcd_barrier_complete(bar, b.x, nloc, nx); b.st[0] = nloc; b.st[1] = nx; }
        const unsigned old = xb_add(&bar[XB_XSUB(b.x)], 1u);
        const unsigned gen = old / nloc;
        if (old + 1u == (gen + 1u) * nloc) {
            __builtin_amdgcn_fence(__ATOMIC_RELEASE, "agent");
            asm volatile("s_waitcnt vmcnt(0)" ::: "memory");
            const unsigned og = xb_add(&bar[XB_TOP], 1u);
            const unsigned tg = og / nx;
            if (og + 1u == (tg + 1u) * nx) xb_add(&bar[XB_TOPGEN], 1u);
            else XB_SPIN(xb_ld(&bar[XB_TOPGEN]) == tg, bar);
            __builtin_amdgcn_fence(__ATOMIC_ACQUIRE, "agent");
            xb_add(&bar[XB_XGEN(b.x)], 1u);
            asm volatile("s_waitcnt vmcnt(0)" ::: "memory");
        } else {
            XB_SPIN(xb_ld(&bar[XB_XGEN(b.x)]) == gen, bar);
            __builtin_amdgcn_fence(__ATOMIC_ACQUIRE, "agent");
            asm volatile("s_waitcnt vmcnt(0)" ::: "memory");
        }
    }
    __syncthreads();
}

struct Frame {
    LAS unsigned char* lds;
    volatile LAS unsigned* MISC;
    gu32* ctl;
    int tid, lane, wave, vcu, G;
};
__device__ __forceinline__ float wave_sum(float v) {
#pragma unroll
    for (int o = 1; o < 64; o <<= 1) v += __shfl_xor(v, o);
    return v;
}
__device__ __forceinline__ float wave_max(float v) {
#pragma unroll
    for (int o = 1; o < 64; o <<= 1) v = fmaxf(v, __shfl_xor(v, o));
    return v;
}

__device__ __forceinline__ void p0_transpose_item(const float* W, int K, int N, bf16* WT, int orow0, const float* gain, LAS unsigned char* T, int k0, int n0, int lane) {
    const int kq = lane >> 4, nl = (lane & 15) * 4;
    const GAS f32x4* src = (const GAS f32x4*)(W + (size_t)(k0 + 16 * kq) * N + n0 + nl);
    f32x4 v[16];
#pragma unroll
    for (int i = 0; i < 16; ++i) v[i] = __builtin_nontemporal_load(&src[(size_t)i * (N / 4)]);
    if (gain) {
        const GAS f32x4* gp = (const GAS f32x4*)(gain + k0 + 16 * kq);
#pragma unroll
        for (int q = 0; q < 4; ++q) { const f32x4 gq = gp[q];
#pragma unroll
            for (int e = 0; e < 4; ++e) v[4 * q + e] = v[4 * q + e] * gq[e]; }
    }
#pragma unroll
    for (int j = 0; j < 4; ++j) {
        const int n = nl + j, sw = (n >> 2) & 7;
        v4u a, b;
        a.x = pk2(v[0][j], v[1][j]); a.y = pk2(v[2][j], v[3][j]); a.z = pk2(v[4][j], v[5][j]); a.w = pk2(v[6][j], v[7][j]);
        b.x = pk2(v[8][j], v[9][j]); b.y = pk2(v[10][j], v[11][j]); b.z = pk2(v[12][j], v[13][j]); b.w = pk2(v[14][j], v[15][j]);
        *(LAS v4u*)(T + n * 128 + (((2 * kq) ^ sw) << 4)) = a;
        *(LAS v4u*)(T + n * 128 + (((2 * kq + 1) ^ sw) << 4)) = b;
    }
    LDS_WAIT(); asm volatile("" ::: "memory");
#pragma unroll
    for (int i = 0; i < 8; ++i) { const int n = 8 * i + (lane >> 3), c = lane & 7;
        const v4u o = *(const LAS v4u*)(T + n * 128 + ((c ^ ((n >> 2) & 7)) << 4));
        *(GAS v4u*)(WT + (size_t)(orow0 + n) * K + k0 + 8 * c) = o; }
    LDS_WAIT(); asm volatile("" ::: "memory");
}
struct Ptrs {
    const float *x, *mix_norm, *ffn_norm, *final_norm, *conv_w_in, *conv_kernel, *conv_w_out, *attn_w_qkv, *attn_w_out, *rel_bias, *w_gate, *w_up, *w_down;
    float* out; unsigned char* ws;
};
__device__ __forceinline__ void convert_layer_weights(Frame& F, const Ptrs& P, int li, int gw, int NGW, int part  ) {
    LAS unsigned char* scr = F.lds + RING_OFF + F.wave * 8192;
    constexpr int I_IN = 16 * 48, I_OUT = 16 * 16, I_G = 16 * 44, I_DN = 44 * 16, I_LAYER = I_IN + I_OUT + 2 * I_G + I_DN;
    const int j = li >> 1;
    bf16* wl = (bf16*)(P.ws + WS_W + (size_t)li * W_LAYER);
    const int it_lo = (part == 2) ? I_LAYER / 2 : 0, it_hi = (part == 1) ? I_LAYER / 2 : I_LAYER;
    for (int it = it_lo + gw; it < it_hi; it += NGW) {
        int r = it;
        if (r < I_IN) {
            const int kb = r / 48, nb = r % 48, n0 = nb * 64;
            if ((li & 1) == 0) {
                int orow; if (n0 < 1024) orow = n0; else if (n0 < 2048) { const int f = n0 - 1024; orow = 1024 + 256 * (f >> 7) + (f & 127); } else { const int f = n0 - 2048; orow = 1024 + 256 * (f >> 7) + 128 + (f & 127); }
                p0_transpose_item(P.conv_w_in + (size_t)j * 1024 * 3072, 1024, 3072, (bf16*)((char*)wl + W_IN_OFF), orow, P.mix_norm + li * 1024, scr, kb * 64, n0, F.lane);
            } else {
                p0_transpose_item(P.attn_w_qkv + (size_t)j * 1024 * 3072, 1024, 3072, (bf16*)((char*)wl + W_IN_OFF), n0, P.mix_norm + li * 1024, scr, kb * 64, n0, F.lane);
            }
            continue;
        }
        r -= I_IN;
        if (r < I_OUT) {
            const int kb = r / 16, nb = r % 16;
            const float* src = ((li & 1) == 0) ? P.conv_w_out + (size_t)j * 1024 * 1024 : P.attn_w_out + (size_t)j * 1024 * 1024;
            p0_transpose_item(src, 1024, 1024, (bf16*)((char*)wl + W_OUT_OFF), nb * 64, nullptr, scr, kb * 64, nb * 64, F.lane);
            continue;
        }
        r -= I_OUT;
        if (r < 2 * I_G) {
            const int up = r >= I_G; if (up) r -= I_G;
            const int kb = r / 44, nb = r % 44, n0 = nb * 64;
            const int orow = 256 * (n0 >> 7) + (up ? 128 : 0) + (n0 & 127);
            p0_transpose_item((up ? P.w_up : P.w_gate) + (size_t)li * 1024 * 2816, 1024, 2816, (bf16*)((char*)wl + W_GU_OFF), orow, P.ffn_norm + li * 1024, scr, kb * 64, n0, F.lane);
            continue;
        }
        r -= 2 * I_G;
        { const int kb = r / 16, nb = r % 16;
          p0_transpose_item(P.w_down + (size_t)li * 2816 * 1024, 2816, 1024, (bf16*)((char*)wl + W_DN_OFF), nb * 64, nullptr, scr, kb * 64, nb * 64, F.lane); }
    }
}
__device__ __forceinline__ void p0_prologue(Frame& F, const Ptrs& P) {
    const int gw = F.vcu * NWAVES + F.wave, NGW = F.G * NWAVES;
    bf16* xb = (bf16*)(P.ws + WS_XB); float* ssq = (float*)(P.ws + WS_SSQ);
    f32x4 xv[4][2][4];
#pragma unroll
    for (int tr = 0; tr < 4; ++tr) { const int m = 2 * gw + 2 * NGW * tr;
        if (m < M) {
#pragma unroll
            for (int rr = 0; rr < 2; ++rr) { const GAS f32x4* xr = (const GAS f32x4*)(P.x + (size_t)(m + rr) * D) + F.lane;
#pragma unroll
                for (int q = 0; q < 4; ++q) xv[tr][rr][q] = __builtin_nontemporal_load(&xr[64 * q]); } } }
    convert_layer_weights(F, P, 0, gw, NGW, 0);
#define P0_ROWS(v_, m_) do { float s[2] = {0.f, 0.f}; \
        _Pragma("unroll") for (int rr = 0; rr < 2; ++rr) { \
            _Pragma("unroll") for (int q = 0; q < 4; ++q) s[rr] += (v_[rr][q].x * v_[rr][q].x + v_[rr][q].y * v_[rr][q].y) + (v_[rr][q].z * v_[rr][q].z + v_[rr][q].w * v_[rr][q].w); \
            s[rr] = wave_sum(s[rr]); \
            GAS unsigned long long* o8 = (GAS unsigned long long*)(xb + (size_t)((m_) + rr) * D) + F.lane; \
            _Pragma("unroll") for (int q = 0; q < 4; ++q) o8[64 * q] = (unsigned long long)pk2(v_[rr][q].x, v_[rr][q].y) | ((unsigned long long)pk2(v_[rr][q].z, v_[rr][q].w) << 32); \
            if (F.lane < 4) ssq[(size_t)F.lane * M + (m_) + rr] = (F.lane == 0) ? s[rr] : 0.f; } } while (0)
#pragma unroll
    for (int tr = 0; tr < 4; ++tr) { const int m = 2 * gw + 2 * NGW * tr; if (m < M) P0_ROWS(xv[tr], m); }
    for (int m = 2 * gw + 8 * NGW; m < M; m += 2 * NGW) {
        f32x4 v[2][4];
#pragma unroll
        for (int rr = 0; rr < 2; ++rr) { const GAS f32x4* xr = (const GAS f32x4*)(P.x + (size_t)(m + rr) * D) + F.lane;
#pragma unroll
            for (int q = 0; q < 4; ++q) v[rr][q] = __builtin_nontemporal_load(&xr[64 * q]); }
        P0_ROWS(v, m);
    }
#undef P0_ROWS
}

__device__ __forceinline__ void unpack8(const v4u w, float (&f)[8]) {
    f32x4 a, b; pg8::unpack8f(w, a, b);
    f[0] = a[0]; f[1] = a[1]; f[2] = a[2]; f[3] = a[3]; f[4] = b[0]; f[5] = b[1]; f[6] = b[2]; f[7] = b[3];
}
__device__ __forceinline__ void conv_pass(Frame& F, const bf16* Bo, const bf16* CU, const float* ck, bf16* G) {
    const int nthr = F.G * NWAVES * 64;
    for (int item = F.vcu * (NWAVES * 64) + F.tid; item < (M / 16) * 128; item += nthr) {
        const int cg = item & 127, rb = item >> 7, t0 = rb * 16, c0 = cg * 8;
        const size_t sg = (size_t)(t0 >> 11) * pg8::SLAB_GAP_BC;
        float k0[8], k1[8], k2[8];
#pragma unroll
        for (int i = 0; i < 8; ++i) { k0[i] = ck[c0 + i]; k1[i] = ck[1024 + c0 + i]; k2[i] = ck[2048 + c0 + i]; }
        float p2[8], p1[8];
        if ((t0 & (SEQ - 1)) == 0) {
#pragma unroll
            for (int i = 0; i < 8; ++i) { p2[i] = 0.f; p1[i] = 0.f; }
        } else {
            unpack8(*(const GAS v4u*)(CU + sg + (size_t)(t0 - 2) * 1024 + c0), p2); unpack8(*(const GAS v4u*)(CU + sg + (size_t)(t0 - 1) * 1024 + c0), p1);
        }
        v4u cw[16], bw[16];
#pragma unroll
        for (int r = 0; r < 16; ++r) { cw[r] = *(const GAS v4u*)(CU + sg + (size_t)(t0 + r) * 1024 + c0); bw[r] = *(const GAS v4u*)(Bo + sg + (size_t)(t0 + r) * 1024 + c0); }
#pragma unroll
        for (int r = 0; r < 16; ++r) {
            float cur[8], bb[8]; unpack8(cw[r], cur); unpack8(bw[r], bb);
            float g[8];
#pragma unroll
            for (int i = 0; i < 8; ++i) { g[i] = bb[i] * (k0[i] * p2[i] + k1[i] * p1[i] + k2[i] * cur[i]); p2[i] = p1[i]; p1[i] = cur[i]; }
            v4u o; o.x = pk2(g[0], g[1]); o.y = pk2(g[2], g[3]); o.z = pk2(g[4], g[5]); o.w = pk2(g[6], g[7]);
            *(GAS v4u*)(G + (size_t)(t0 + r) * 1024 + c0) = o;
        }
    }
}

__device__ __forceinline__ int t5_bucket(int d) {
    if (d < 16) return d;
    int b = 16;
    b += (d >= 22); b += (d >= 30); b += (d >= 40); b += (d >= 54); b += (d >= 73); b += (d >= 99); b += (d >= 134); b += (d >= 182);
    b += (d >= 246); b += (d >= 332); b += (d >= 450); b += (d >= 609); b += (d >= 825); b += (d >= 1117); b += (d >= 1513);
    return b;
}
__device__ __forceinline__ void attn_simple(Frame& F, const bf16* QKV, const float* rel_bias, bf16* O) {
    LAS float* qs = (LAS float*)(F.lds + RING_OFF + F.wave * 4096);
    LAS float* ps = qs + 64;
    const int gw = F.vcu * NWAVES + F.wave, NGW = F.G * NWAVES, lane = F.lane;
    for (int pair = gw; pair < M * NH; pair += NGW) {
        const int tok = pair >> 4, h = pair & 15, t = tok & (SEQ - 1), rowbase = tok - t;
        qs[lane] = bf2f(QKV[(size_t)tok * 3072 + h * 64 + lane]);
        LDS_WAIT(); asm volatile("" ::: "memory");
        float sv[7]; float mx = -1e30f;
#pragma unroll
        for (int rnd = 0; rnd < 7; ++rnd) {
            const int e = rnd * 64 + lane; const int g = e / 129, j = e - g * 129; const int dil = (g == 0) ? 1 : (g == 1) ? 4 : 16; const int tk = t - j * dil;
            float s = -1e30f;
            if (e < 387 && tk >= 0) {
                const GAS v4u* kr = (const GAS v4u*)(QKV + (size_t)(rowbase + tk) * 3072 + 1024 + h * 64);
                float dot = 0.f;
#pragma unroll
                for (int c = 0; c < 8; ++c) { float kf[8]; unpack8(kr[c], kf);
#pragma unroll
                    for (int i = 0; i < 8; ++i) dot += qs[c * 8 + i] * kf[i]; }
                s = dot + rel_bias[t5_bucket(j * dil) * NH + h] * LOG2E;
            }
            sv[rnd] = s; mx = fmaxf(mx, s);
        }
        mx = wave_max(mx);
        float sum = 0.f;
#pragma unroll
        for (int rnd = 0; rnd < 7; ++rnd) { const float p = __builtin_amdgcn_exp2f(sv[rnd] - mx); sum += p; ps[rnd * 64 + lane] = p; }
        sum = wave_sum(sum);
        LDS_WAIT(); asm volatile("" ::: "memory");
        float acc = 0.f;
        for (int g = 0; g < 3; ++g) { const int dil = (g == 0) ? 1 : (g == 1) ? 4 : 16;
            for (int j = 0; j < 129; ++j) { const int tk = t - j * dil; if (tk < 0) break;
                acc += ps[g * 129 + j] * bf2f(QKV[(size_t)(rowbase + tk) * 3072 + 2048 + h * 64 + lane]); } }
        O[(size_t)tok * 1024 + h * 64 + lane] = (bf16)f2bf(acc / sum);
        LDS_WAIT(); asm volatile("" ::: "memory");
    }
}


#ifndef FORCE_SLOWSM
#define FORCE_SLOWSM 0
#endif
namespace att {
constexpr bool FASTSM = (USE_F16 == 0);
typedef short bf16x8 __attribute__((ext_vector_type(8)));
typedef short s16x4 __attribute__((ext_vector_type(4)));
typedef short v4i16_t __attribute__((ext_vector_type(4)));
typedef float f32x16 __attribute__((ext_vector_type(16)));
typedef float f32x2_t __attribute__((ext_vector_type(2))); typedef __bf16 bf16x2_t __attribute__((ext_vector_type(2)));
constexpr int KIMG_OFF = 0, VIMG_OFF = 49152, WL_OFF = 98304, WL_BYTES = 5120, TBL_OFF = WL_OFF + 8 * WL_BYTES;
constexpr int TBL_CP = 208, TBL_G = 4 * TBL_CP;
static_assert(TBL_OFF + 3 * TBL_G * 4 <= LDSCTL_OFF, "attention LDS map");
__device__ __forceinline__ int crow(int r, int hi) { return (r & 3) + 8 * (r >> 2) + 4 * hi; }
__device__ __forceinline__ unsigned cvtpk(float lo, float hi) { return pg8::cvt_pk_bf16(lo, hi); }
#if USE_F16
#define ATT_MFMA32(a, b, c) __builtin_amdgcn_mfma_f32_32x32x16_f16(__builtin_bit_cast(pg8::h16x8, (a)), __builtin_bit_cast(pg8::h16x8, (b)), (c), 0, 0, 0)
#else
#define ATT_MFMA32(a, b, c) __builtin_amdgcn_mfma_f32_32x32x16_bf16((a), (b), (c), 0, 0, 0)
#endif
__device__ __forceinline__ s16x4 vtr(const LAS unsigned char* p) { return __builtin_bit_cast(s16x4, __builtin_amdgcn_ds_read_tr16_b64_v4i16((LAS v4i16_t*)p)); }
__device__ __forceinline__ void build_tables(Frame& F, const float* rel_bias, int h) {
    LAS float* tbl = (LAS float*)(F.lds + TBL_OFF);
    for (int i = F.tid; i < 3 * TBL_G; i += NWAVES * 64) { const int g = i / TBL_G, e = i % TBL_G, s = e / TBL_CP, m = e % TBL_CP; const int n = m + s, rel = 159 - n;
        const int dil = (g == 0) ? 1 : (g == 1) ? 4 : 16;
        tbl[i] = (n < 192 && rel >= 0 && rel <= 128) ? rel_bias[t5_bucket(rel * dil) * NH + h] * LOG2E : -1e30f; }
}
template <int PH>
__device__ __forceinline__ void attn_phase(Frame& F, const bf16* QKV, const float* rel_bias, bf16* MIXp, bf16* O1p, float* LSE) {
    const int bh = F.vcu >> 1, c = F.vcu & 1, b = bh >> 4, h = bh & 15, w = F.wave, lane = F.lane;
    const int c31 = lane & 31, hi = lane >> 5;
    const size_t rowb = (size_t)b * SEQ;
    O1p += (size_t)b * 2097152; LSE = (float*)((char*)LSE + (size_t)b * (8u << 20) + (4u << 20));
    LAS unsigned char* Kimg = F.lds + KIMG_OFF; LAS unsigned char* Vimg = F.lds + VIMG_OFF;
    LAS unsigned char* wl = F.lds + WL_OFF + w * WL_BYTES;
    LAS float* wsf = (LAS float*)(wl + 4096);
    const LAS float* tblb = (const LAS float*)(F.lds + TBL_OFF);
    constexpr int NCH = (PH == 0) ? 8 : 4;
#define ATT_CHUNK(ci_, g_, resA_, resB_, c0_) do { if (PH == 0) { const int id_ = c + 2 * (ci_); \
            if (id_ < 8) { g_ = 0; resA_ = 0; c0_ = 256 * id_; } else { g_ = 1; resA_ = (id_ - 8) >> 1; c0_ = 256 * (((id_ - 8) & 1) ^ (((id_ - 8) >> 1) & 1)); } resB_ = resA_; } \
        else { const int id_ = c * 4 + (ci_); g_ = 2; resA_ = 2 * id_; resB_ = 2 * id_ + 1; c0_ = 0; } } while (0)
    const int lane_lr = (w < 4) ? 8 * w + (lane >> 3) : 16 * ((w - 4) & 1) + (lane >> 2);
    const int lane_co = (w < 4) ? 1024 + h * 64 + 8 * ((lane & 7) ^ ((4 * (w & 1) + (lane >> 4)) & 7)) : 2048 + h * 64 + 32 * ((w - 4) >> 1) + 8 * (lane & 3);
#define ATT_LOADCHUNK(ci_) do { int g_, ra_, rb_, c0_; ATT_CHUNK(ci_, g_, ra_, rb_, c0_); const int dil_ = (g_ == 0) ? 1 : (g_ == 1) ? 4 : 16; (void)rb_; \
        const size_t stride_ = (size_t)32 * dil_ * 3072; \
        if (PH == 0) { const bf16* base_ = QKV + ((long)rowb + (long)((c0_ - 128 + lane_lr) * dil_ + ra_)) * 3072 + lane_co; \
            if (c0_ != 0) { _Pragma("unroll") for (int i = 0; i < 4; ++i) pre[i] = *(const GAS v4u*)(base_ + i * stride_); } \
            _Pragma("unroll") for (int i = 4; i < 12; ++i) pre[i] = *(const GAS v4u*)(base_ + i * stride_); } \
        else { const bf16* base_ = QKV + (rowb + (size_t)(lane_lr * dil_ + ra_)) * 3072 + lane_co; \
            _Pragma("unroll") for (int i = 4; i < 8; ++i) { pre[i] = *(const GAS v4u*)(base_ + (i - 4) * stride_); pre[i + 4] = *(const GAS v4u*)(base_ + 3072 + (i - 4) * stride_); } } } while (0)
    v4u pre[12];
#define ATT_LOADQ(ci_) do { int g_, ra_, rb_, c0_; ATT_CHUNK(ci_, g_, ra_, rb_, c0_); const int dil_ = (g_ == 0) ? 1 : (g_ == 1) ? 4 : 16; \
        const int res_ = (PH == 1 && w >= 4) ? rb_ : ra_; const int m0_ = (PH == 1) ? 32 * ((w < 4) ? w : 7 - w) : c0_ + 32 * w; \
        const bf16* qp_ = QKV + (rowb + (size_t)((m0_ + c31) * dil_ + res_)) * 3072 + h * 64 + 8 * hi; \
        _Pragma("unroll") for (int s = 0; s < 4; ++s) qf[s] = *(const bf16x8*)(qp_ + 16 * s); } while (0)
    ATT_LOADCHUNK(0);
    if (PH == 0) build_tables(F, rel_bias, h);
    for (int ci = 0; ci < NCH; ++ci) {
        int g, resA, resB, c0; ATT_CHUNK(ci, g, resA, resB, c0);
        const int dil = (g == 0) ? 1 : (g == 1) ? 4 : 16;
        const int res = (PH == 1 && w >= 4) ? resB : resA;
        const int m0 = (PH == 1) ? 32 * ((w < 4) ? w : 7 - w) : c0 + 32 * w;
        const int tb0 = (PH == 1) ? ((w < 4) ? 0 : 4) + (m0 >> 5) : w;
        const int nskip = (m0 >= 128) ? 0 : 4 - (m0 >> 5);
        bf16x8 qf[4]; ATT_LOADQ(ci);
        __syncthreads();
        { LAS unsigned char* dst = ((w < 4) ? Kimg + w * 1024 : Vimg + (w - 4) * 1024) + lane * 16;
          if (PH == 0 && c0 != 0) {
#pragma unroll
            for (int i = 0; i < 4; ++i) *(LAS v4u*)(dst + i * 4096) = pre[i]; }
#pragma unroll
          for (int i = 4; i < 12; ++i) *(LAS v4u*)(dst + i * 4096) = pre[i]; }
        const int tq = (m0 + c31) * dil + res;
        float l0n = 0.f, l1n = 0.f;
        if (PH == 1) { l0n = LSE[(size_t)tq * NH + h]; l1n = LSE[((size_t)SEQ + tq) * NH + h]; }
        LDS_WAIT();
        __syncthreads();
        if (ci + 1 < NCH) ATT_LOADCHUNK(ci + 1);
        float mx = 0.f, ls = 0.f;
        f32x16 o[2];
        float zacc = 0.f; asm volatile("" : "+v"(zacc));
#pragma unroll
        for (int r = 0; r < 16; ++r) { o[0][r] = zacc; o[1][r] = zacc; }
        const int loff = ((lane >> 4) & 1) * 32 + (lane & 3) * 8 + (4 * hi + ((lane & 15) >> 2)) * 64;
        const int ta = 31 - c31 + 4 * hi, ts = ta & 3; const LAS f32x4* tb = (const LAS f32x4*)(tblb + g * TBL_G + ts * TBL_CP + (ta - ts));
        const LAS unsigned char* kbase = Kimg + tb0 * 4096 + c31 * 128; const LAS unsigned char* vbase = Vimg + tb0 * 4096;
#define ATT_QK(dst, kt_) do { const LAS f32x4* tq_ = tb + 8 * (kt_); _Pragma("unroll") for (int j = 0; j < 4; ++j) { const f32x4 t4 = tq_[2 * j]; dst[4 * j + 0] = t4[0]; dst[4 * j + 1] = t4[1]; dst[4 * j + 2] = t4[2]; dst[4 * j + 3] = t4[3]; } \
                const LAS unsigned char* kp_ = kbase + (kt_) * 4096; \
                _Pragma("unroll") for (int s = 0; s < 4; ++s) { const bf16x8 kf = *(const LAS bf16x8*)(kp_ + (((2 * s + hi) ^ ((c31 >> 1) & 7)) << 4)); dst = ATT_MFMA32(kf, qf[s], dst); } } while (0)
#define ATT_PV(a_, kt_) do { const LAS unsigned char* slot = vbase + (kt_) * 4096; \
                _Pragma("unroll") for (int ks = 0; ks < 2; ++ks) { \
                    v4u pw; pw.x = cvtpk(a_[8 * ks + 0], a_[8 * ks + 1]); pw.y = cvtpk(a_[8 * ks + 2], a_[8 * ks + 3]); pw.z = cvtpk(a_[8 * ks + 4], a_[8 * ks + 5]); pw.w = cvtpk(a_[8 * ks + 6], a_[8 * ks + 7]); \
                    const bf16x8 pa = __builtin_bit_cast(bf16x8, pw); \
                    osum = ATT_MFMA32(ones, pa, osum); \
                    _Pragma("unroll") for (int dh = 0; dh < 2; ++dh) { \
                        const s16x4 lo = vtr(slot + (dh * 2 + ks) * 1024 + loff), hh = vtr(slot + (dh * 2 + ks) * 1024 + loff + 512); \
                        const bf16x8 vb = (bf16x8){lo[0], lo[1], lo[2], lo[3], hh[0], hh[1], hh[2], hh[3]}; \
                        o[dh] = ATT_MFMA32(pa, vb, o[dh]); } } } while (0)
        f32x16 osum;
#pragma unroll
        for (int r = 0; r < 16; ++r) osum[r] = zacc;
        bf16x8 ones = (bf16x8){(short)0x3F80, (short)0x3F80, (short)0x3F80, (short)0x3F80, (short)0x3F80, (short)0x3F80, (short)0x3F80, (short)0x3F80};
        asm volatile("" : "+v"(ones));
        if (FASTSM) {
            int kt = 4; f32x16 an; ATT_QK(an, 4);
            for (;;) {
                f32x16 a = an;
                const int kn = (kt > nskip) ? kt - 1 : kt;
                ATT_QK(an, kn);
#pragma unroll
                for (int r = 0; r < 16; ++r) a[r] = __builtin_amdgcn_exp2f(a[r]);
                ATT_PV(a, kt);
                if (kt == nskip) break;
                --kt;
            }
            ls = osum[0];
        }
        { const float lt = ls;
          const bool redo = !FASTSM || FORCE_SLOWSM || !(lt > 1e-30f && lt < 1e30f);
          if (__builtin_expect(__any(redo), !FASTSM || FORCE_SLOWSM)) {
            mx = -1e30f;
            for (int kt = 4; kt >= nskip; --kt) { f32x16 a; ATT_QK(a, kt);
#pragma unroll
                for (int r = 0; r < 16; ++r) mx = fmaxf(mx, a[r]); }
            mx = fmaxf(mx, __shfl_xor(mx, 32));
            { float z = 0.f; asm volatile("" : "+v"(z));
#pragma unroll
              for (int r = 0; r < 16; ++r) { o[0][r] = z; o[1][r] = z; osum[r] = z; } }
            for (int kt = 4; kt >= nskip; --kt) { f32x16 a; ATT_QK(a, kt);
#pragma unroll
                for (int r = 0; r < 16; ++r) a[r] = __builtin_amdgcn_exp2f(a[r] - mx);
                ATT_PV(a, kt); }
            ls = osum[0];
          }
        }
#undef ATT_QK
#undef ATT_PV
        v4u m0w[4], o1w[4];
        if (PH == 1) {
#pragma unroll
            for (int i = 0; i < 4; ++i) { const int row = i * 8 + (lane >> 3), ch = lane & 7;
                const size_t off = (rowb + (size_t)((m0 + row) * dil + res)) * 1024 + h * 64 + ch * 8;
                m0w[i] = *(const GAS v4u*)(MIXp + off); o1w[i] = *(const GAS v4u*)(O1p + off); }
        }
        if (hi == 0) wsf[c31] = __builtin_amdgcn_rcpf(ls);
        float a0w = 0.f, a1w = 0.f, a2w = 0.f;
        if (PH == 1) {
            const float l2 = mx + __builtin_amdgcn_logf(ls), l0 = l0n, l1 = l1n;
            const float mm = fmaxf(l2, fmaxf(l0, l1)); const float w0 = __builtin_amdgcn_exp2f(l0 - mm), w1 = __builtin_amdgcn_exp2f(l1 - mm), w2 = __builtin_amdgcn_exp2f(l2 - mm);
            const float iw = __builtin_amdgcn_rcpf(w0 + w1 + w2);
            if (hi == 0) { wsf[32 + 3 * c31 + 0] = w0 * iw; wsf[32 + 3 * c31 + 1] = w1 * iw; wsf[32 + 3 * c31 + 2] = w2 * iw; }
        }
        LDS_WAIT(); asm volatile("" ::: "memory");
        LAS bf16* stg = (LAS bf16*)wl;
#pragma unroll
        for (int r = 0; r < 16; ++r) { const int qr = crow(r, hi); const float rl = wsf[qr];
            const unsigned pk = cvtpk(o[0][r] * rl, o[1][r] * rl);
            stg[qr * 64 + c31] = (bf16)(pk & 0xffffu); stg[qr * 64 + 32 + c31] = (bf16)(pk >> 16); }
        LDS_WAIT(); asm volatile("" ::: "memory");
        if (PH == 0) {
            bf16* Odst = (g == 0) ? MIXp : O1p;
#pragma unroll
            for (int i = 0; i < 4; ++i) { const int row = i * 8 + (lane >> 3), ch = lane & 7; const v4u v = *(const LAS v4u*)(stg + row * 64 + ch * 8);
                *(GAS v4u*)(Odst + (rowb + (size_t)((m0 + row) * dil + res)) * 1024 + h * 64 + ch * 8) = v; }
            if (hi == 0) LSE[((size_t)g * SEQ + tq) * NH + h] = mx + __builtin_amdgcn_logf(ls);
        } else {
#pragma unroll
            for (int i = 0; i < 4; ++i) { const int row = i * 8 + (lane >> 3), ch = lane & 7;
                a0w = wsf[32 + 3 * row + 0]; a1w = wsf[32 + 3 * row + 1]; a2w = wsf[32 + 3 * row + 2];
                const size_t off = (rowb + (size_t)((m0 + row) * dil + res)) * 1024 + h * 64 + ch * 8;
                float f0[8], f1[8], f2[8]; unpack8(m0w[i], f0); unpack8(o1w[i], f1); unpack8(*(const LAS v4u*)(stg + row * 64 + ch * 8), f2);
                float y[8];
#pragma unroll
                for (int e = 0; e < 8; ++e) y[e] = a0w * f0[e] + a1w * f1[e] + a2w * f2[e];
                v4u ov; ov.x = pk2(y[0], y[1]); ov.y = pk2(y[2], y[3]); ov.z = pk2(y[4], y[5]); ov.w = pk2(y[6], y[7]);
                *(GAS v4u*)(MIXp + off) = ov; }
        }
        LDS_WAIT(); asm volatile("" ::: "memory");
    }
    __syncthreads();
#undef ATT_CHUNK
#undef ATT_LOADCHUNK
#undef ATT_LOADQ
}
}

__device__ __forceinline__ void final_norm_pass(Frame& F, const bf16* xb, const float* g, float* out) {
    const int gw = F.vcu * NWAVES + F.wave;
    f32x4 gv[4];
#pragma unroll
    for (int q = 0; q < 2; ++q) { gv[2 * q] = ((const GAS f32x4*)g)[128 * q + 2 * F.lane]; gv[2 * q + 1] = ((const GAS f32x4*)g)[128 * q + 2 * F.lane + 1]; }
    v4u xw[8][2];
#pragma unroll
    for (int kk = 0; kk < 8; ++kk) { const int m = SEQ * (gw >> 8) + (gw & 255) + 256 * kk; const GAS v4u* xr = (const GAS v4u*)(xb + (size_t)m * D) + F.lane; xw[kk][0] = xr[0]; xw[kk][1] = xr[64]; }
#pragma unroll
    for (int kk = 0; kk < 8; ++kk) { const int m = SEQ * (gw >> 8) + (gw & 255) + 256 * kk;
        float v[2][8]; float s = 0.f;
#pragma unroll
        for (int q = 0; q < 2; ++q) { unpack8(xw[kk][q], v[q]);
#pragma unroll
            for (int e = 0; e < 8; ++e) s += v[q][e] * v[q][e]; }
        const float rstd = 1.0f / sqrtf(wave_sum(s) * (1.0f / D) + 1e-6f);
        GAS f32x4* o = (GAS f32x4*)(out + (size_t)m * D);
#pragma unroll
        for (int q = 0; q < 2; ++q) {
            __builtin_nontemporal_store((f32x4){v[q][0], v[q][1], v[q][2], v[q][3]} * rstd * gv[2 * q], &o[128 * q + 2 * F.lane]);
            __builtin_nontemporal_store((f32x4){v[q][4], v[q][5], v[q][6], v[q][7]} * rstd * gv[2 * q + 1], &o[128 * q + 2 * F.lane + 1]); }
    }
}


constexpr int RSTD_OFF = RING_BYTES;
constexpr int XPOSE_OFF = RSTD_OFF + 6144;
static_assert(XPOSE_OFF + 8 * 2048 <= LDSCTL_OFF, "epilogue turn slots");
struct RstdOrder : pg8::StaticOrder {
    float p[3][4]; LAS float* tab; int tid;
    __device__ __forceinline__ void load(Frame& F, const float* ssq) {
        tab = (LAS float*)(F.lds + RSTD_OFF); tid = F.tid;
        pg8::Unit u;
#pragma unroll
        for (int k = 0; k < 3; ++k) { const int ui = 2 * k + (tid >> 8);
            if (next(ui, u)) { const int row = u.pm * 256 + (tid & 255);
#pragma unroll
                for (int q = 0; q < 4; ++q) p[k][q] = ssq[(size_t)q * M + row]; }
            else {
#pragma unroll
                for (int q = 0; q < 4; ++q) p[k][q] = 1.0f; } }
    }
    __device__ __forceinline__ void after_first_stage() const {
#pragma unroll
        for (int k = 0; k < 3; ++k) tab[(2 * k + (tid >> 8)) * 256 + (tid & 255)] = __builtin_amdgcn_rsqf(((p[k][0] + p[k][1]) + (p[k][2] + p[k][3])) * (1.0f / 1024.0f) + 1e-6f);
    }
};

struct EpiResFinal {
    static constexpr bool PERM = true, AFTER_DRAIN = true;
    const bf16* xb; float* ssq; const float* gfin; float* out; const XcdBarrier* bar; unsigned* lseq; bool local_mode; bool do_final;
    __device__ __forceinline__ void fused(pg8::f32x4 (&acc)[2][2][4][2], const pg8::Unit& u, int wr, int wc, int fr, int fq, LAS unsigned char* lds, int wid, int lane) const {
        LAS float* Pt = (LAS float*)lds;
        LAS float* Rt = (LAS float*)(lds + 4096);
        const int col0 = u.pn * 256 + wc * 32 + 8 * fq;
        pg8::u32x4 xr[2][4][2];
#pragma unroll
        for (int ai = 0; ai < 2; ++ai)
#pragma unroll
            for (int m = 0; m < 4; ++m) { const size_t off = (size_t)(u.pm * 256 + ai * 128 + wr * 64 + m * 16 + fr) * 1024 + col0;
#pragma unroll
                for (int bj = 0; bj < 2; ++bj) xr[ai][m][bj] = *(const pg8::u32x4*)(xb + off + bj * 128); }
#pragma unroll
        for (int ai = 0; ai < 2; ++ai)
#pragma unroll
            for (int m = 0; m < 4; ++m) { const int rl = ai * 128 + wr * 64 + m * 16 + fr; float s = 0.f;
#pragma unroll
                for (int bj = 0; bj < 2; ++bj) { pg8::f32x4 x0, x1; pg8::unpack8f(xr[ai][m][bj], x0, x1);
                    const pg8::f32x4 v0 = acc[ai][bj][m][0] + x0, v1 = acc[ai][bj][m][1] + x1;
                    acc[ai][bj][m][0] = v0; acc[ai][bj][m][1] = v1;
                    s += (v0[0] * v0[0] + v0[1] * v0[1]) + (v0[2] * v0[2] + v0[3] * v0[3]) + (v1[0] * v1[0] + v1[1] * v1[1]) + (v1[2] * v1[2] + v1[3] * v1[3]); }
                s += __shfl_xor(s, 16); s += __shfl_xor(s, 32);
                if (fq == 0) Pt[rl * 4 + wc] = s; }
        LDS_WAIT(); __syncthreads();
        const int t = wid * 64 + lane;
        if (t < 256) { const pg8::f32x4 p = *(const LAS pg8::f32x4*)(Pt + t * 4); ssq[(size_t)u.pn * M + u.pm * 256 + t] = (p[0] + p[1]) + (p[2] + p[3]); }
        if (!do_final) return;
        if (local_mode) xcc_local_barrier(*bar, *lseq); else xcd_barrier(*bar);
        if (t < 256) { const int row = u.pm * 256 + t;
            const float sq = (ssq[row] + ssq[(size_t)M + row]) + (ssq[(size_t)2 * M + row] + ssq[(size_t)3 * M + row]);
            Rt[t] = 1.0f / sqrtf(sq * (1.0f / D) + 1e-6f); }
        pg8::f32x4 gv[2][2];
#pragma unroll
        for (int bj = 0; bj < 2; ++bj) { gv[bj][0] = *(const GAS pg8::f32x4*)(gfin + col0 + bj * 128); gv[bj][1] = *(const GAS pg8::f32x4*)(gfin + col0 + bj * 128 + 4); }
        LDS_WAIT(); __syncthreads();
#pragma unroll
        for (int ai = 0; ai < 2; ++ai)
#pragma unroll
            for (int m = 0; m < 4; ++m) { const int rl = ai * 128 + wr * 64 + m * 16 + fr; const float rs = Rt[rl];
                float* orow = out + (size_t)(u.pm * 256 + rl) * 1024 + col0;
#pragma unroll
                for (int bj = 0; bj < 2; ++bj) {
                    __builtin_nontemporal_store(acc[ai][bj][m][0] * rs * gv[bj][0], (GAS pg8::f32x4*)(orow + bj * 128));
                    __builtin_nontemporal_store(acc[ai][bj][m][1] * rs * gv[bj][1], (GAS pg8::f32x4*)(orow + bj * 128 + 4)); } }
    }
};

#ifndef ATTN_SIMPLE
#define ATTN_SIMPLE 0
#endif
#ifndef DUP_G1
#define DUP_G1 0
#endif
#ifndef DUP_G3
#define DUP_G3 0
#endif
#ifndef DUP_P0
#define DUP_P0 0
#endif
#ifndef DUP_BAR
#define DUP_BAR 0
#endif
#ifndef NO_LOCAL
#define NO_LOCAL 0
#endif
#ifndef DUP_ATT
#define DUP_ATT 0
#endif
#ifndef DUP_CONV
#define DUP_CONV 0
#endif
constexpr int NPHASE = 2 + 6 * DEPTH;
struct Args { const float* in[13]; float* out; unsigned char* ws; int ph_lo, ph_hi; };
__global__ void __launch_bounds__(NWAVES * 64, 2) mk_fwd(Args args) {
    extern __shared__ __attribute__((aligned(16))) unsigned char lds[];
    Frame F;
    F.lds = (LAS unsigned char*)lds;
    F.MISC = (volatile LAS unsigned*)(F.lds + MISC_OFF);
    F.tid = threadIdx.x; F.lane = F.tid & 63; F.wave = __builtin_amdgcn_readfirstlane(F.tid >> 6);
    F.G = gridDim.x; { const int bx = blockIdx.x; F.vcu = (F.G % 8 == 0) ? (bx % 8) * (F.G / 8) + bx / 8 : bx; }
    unsigned char* ws = args.ws;
    F.ctl = (gu32*)(ws + WS_CTL);
    Ptrs P;
    P.x = args.in[0]; P.mix_norm = args.in[1]; P.ffn_norm = args.in[2]; P.final_norm = args.in[3]; P.conv_w_in = args.in[4]; P.conv_kernel = args.in[5]; P.conv_w_out = args.in[6];
    P.attn_w_qkv = args.in[7]; P.attn_w_out = args.in[8]; P.rel_bias = args.in[9]; P.w_gate = args.in[10]; P.w_up = args.in[11]; P.w_down = args.in[12]; P.out = args.out; P.ws = ws;
    for (int u = F.tid; u < (LDS_BYTES - LDSCTL_OFF) / 4; u += NWAVES * 64) ((LAS unsigned*)(F.lds + LDSCTL_OFF))[u] = 0u;
    __syncthreads();
    XcdBarrier bar = xcd_barrier_post((unsigned*)(F.ctl + CW_BAR), F.MISC + 8);
    int cid = (int)blockIdx.x;
    bool local_mode = false; unsigned lseq = 0u;
    bf16* XB = (bf16*)(ws + WS_XB); float* SSQ = (float*)(ws + WS_SSQ); bf16* ACT = (bf16*)(ws + WS_ACT); bf16* MIX = (bf16*)(ws + WS_MIX);
    const int lo = args.ph_lo, hi = args.ph_hi;
#define IN(k) (lo <= (k) && (k) < hi)
#if DUP_G1
#define REPG1(...) { __VA_ARGS__ __VA_ARGS__ }
#else
#define REPG1(...) __VA_ARGS__
#endif
#if DUP_G3
#define REPG3(...) { __VA_ARGS__ __VA_ARGS__ }
#else
#define REPG3(...) __VA_ARGS__
#endif
#if DUP_ATT
#define REPATT(...) { __VA_ARGS__ __syncthreads(); __VA_ARGS__ }
#else
#define REPATT(...) __VA_ARGS__
#endif
#if DUP_CONV
#define REPCONV(...) { __VA_ARGS__ __syncthreads(); __VA_ARGS__ }
#else
#define REPCONV(...) __VA_ARGS__
#endif
#define SEAMG(k) do { if (IN(k) && IN((k) + 1)) { xcd_barrier(bar); if (DUP_BAR) xcd_barrier(bar); } } while (0)
#define SEAM(k) do { if (IN(k) && IN((k) + 1)) { if (local_mode) xcc_local_barrier(bar, lseq); else xcd_barrier(bar); if (DUP_BAR) { if (local_mode) xcc_local_barrier(bar, lseq); else xcd_barrier(bar); } } } while (0)
    if (IN(0)) { p0_prologue(F, P); if (DUP_P0) { __syncthreads(); p0_prologue(F, P); } } SEAMG(0);
    if (lo == 0 && hi == NPHASE && F.G == 256 && !NO_LOCAL) {
        if (F.tid == 0) { unsigned ok = 1u;
#pragma unroll
            for (unsigned jx = 0; jx < 16; ++jx) { const unsigned cx = xb_ld(&bar.bar[XB_XCNT(jx)]); ok &= (cx == (jx < 8u ? 32u : 0u)) ? 1u : 0u; }
            F.MISC[11] = ok; }
        __syncthreads();
        local_mode = F.MISC[11] != 0u;
        if (local_mode) { const int rank = (int)F.MISC[10], xcc = (int)bar.x; cid = rank * 8 + xcc; F.vcu = xcc * 32 + rank; }
    }
#define WREADY(l) (12288 + 16 * (l))
    const bool wflag = local_mode && F.G == 256 && IN(0) && IN(NPHASE - 1);
#define LAYER(li) do { \
        constexpr int j = (li) >> 1; constexpr bool is_attn = ((li) & 1) != 0; constexpr int p0 = 1 + 6 * (li); \
        const unsigned char* wl = ws + WS_W + (size_t)(li) * W_LAYER; \
        if (IN(p0)) REPG1({ pg8::Gemm g{XB, (const bf16*)(wl + W_IN_OFF), M, 3072, 1024}; RstdOrder S; S.init(M, 3072, F.G, cid); S.load(F, SSQ); \
            if (is_attn) { pg8::EpiQKV E{ACT, (const LAS float*)(F.lds + RSTD_OFF), C2, F.lds + XPOSE_OFF}; pg8::gemm_phase<pg8::EpiQKV, RstdOrder, true, true>(F.lds + RING_OFF, g, S, E); } \
            else { pg8::EpiConvIn E{ACT, ACT + pg8::SLAB_CU_OFF, (const LAS float*)(F.lds + RSTD_OFF), F.lds + XPOSE_OFF}; pg8::gemm_phase<pg8::EpiConvIn, RstdOrder, true, true>(F.lds + RING_OFF, g, S, E); } }) \
        SEAM(p0); \
        if (IN(p0 + 1)) { if (is_attn) REPATT({ if (ATTN_SIMPLE) attn_simple(F, ACT, P.rel_bias, MIX); else att::attn_phase<0>(F, ACT, P.rel_bias, MIX, (bf16*)P.out, (float*)P.out); }) \
                          else REPCONV({ conv_pass(F, ACT, ACT + pg8::SLAB_CU_OFF, P.conv_kernel + (size_t)j * 3 * 1024, MIX); }) } \
        SEAM(p0 + 1); \
        if (is_attn && !ATTN_SIMPLE) { if (IN(p0 + 2)) att::attn_phase<1>(F, ACT, P.rel_bias, MIX, (bf16*)P.out, (float*)P.out); SEAM(p0 + 2); } \
        if (IN(p0 + 3)) { pg8::Gemm g{MIX, (const bf16*)(wl + W_OUT_OFF), M, 1024, 1024}; pg8::StaticOrder S; S.init(M, 1024, F.G, cid); \
            pg8::EpiRes E{XB, SSQ}; pg8::gemm_phase<pg8::EpiRes, pg8::StaticOrder, false, true>(F.lds + RING_OFF, g, S, E); } \
        SEAM(p0 + 3); \
        if (IN(p0 + 4)) { if ((li) + 1 < DEPTH && cid >= 128) { convert_layer_weights(F, P, (li) + 1, (cid - 128) * NWAVES + F.wave, 128 * NWAVES, 1); __syncthreads(); } } \
        if (IN(p0 + 4)) REPG3({ pg8::Gemm g{XB, (const bf16*)(wl + W_GU_OFF), M, 5632, 1024}; RstdOrder S; S.init(M, 5632, F.G, cid); S.load(F, SSQ); \
            pg8::EpiSwiGLU E{ACT, (const LAS float*)(F.lds + RSTD_OFF), F.lds + XPOSE_OFF}; pg8::gemm_phase<pg8::EpiSwiGLU, RstdOrder, true, true>(F.lds + RING_OFF, g, S, E); }) \
        if (IN(p0 + 4)) { if ((li) + 1 < DEPTH && cid >= 128) { __syncthreads(); convert_layer_weights(F, P, (li) + 1, (cid - 128) * NWAVES + F.wave, 128 * NWAVES, 2); \
            if (wflag) { asm volatile("s_waitcnt vmcnt(0)" ::: "memory"); __syncthreads(); \
                if (F.tid == 0) { __builtin_amdgcn_fence(__ATOMIC_RELEASE, "agent"); asm volatile("s_waitcnt vmcnt(0)" ::: "memory"); xb_add(&bar.bar[WREADY((li) + 1)], 1u); } } } } \
        SEAM(p0 + 4); \
        if (IN(p0 + 5)) { pg8::Gemm g{ACT, (const bf16*)(wl + W_DN_OFF), M, 1024, 2816, (long)(pg8::SLAB_GAP_HID * 2)}; pg8::StaticOrder S; S.init(M, 1024, F.G, cid); \
            if ((li) + 1 < DEPTH) { pg8::EpiRes E{XB, SSQ}; pg8::gemm_phase<pg8::EpiRes, pg8::StaticOrder, false, true>(F.lds + RING_OFF, g, S, E); } \
            else { EpiResFinal E{XB, SSQ, P.final_norm, P.out, &bar, &lseq, local_mode, IN(NPHASE - 1)}; pg8::gemm_phase<EpiResFinal, pg8::StaticOrder, false, true>(F.lds + RING_OFF, g, S, E); } } \
        if ((li) + 1 < DEPTH) { if (wflag) { if (F.tid == 0) XB_SPIN(xb_ld(&bar.bar[WREADY((li) + 1)]) < 128u, bar.bar);     \
                SEAM(p0 + 5); } \
            else SEAMG(p0 + 5); } \
    } while (0)
    LAYER(0); LAYER(1); LAYER(2); LAYER(3);
}

#ifndef MK_PER_PHASE
#define MK_PER_PHASE 0
#endif
extern "C" void kernel_launch(void* const* d_in, const int* in_sizes, int n_in, void* d_out, int out_size, void* d_ws, size_t ws_size, hipStream_t stream) {
    static int grid = 0;
    if (grid == 0) {
        if (n_in != 13 || in_sizes[0] != M * D || out_size != M * D || ws_size < WS_END) { fprintf(stderr, "kernel_launch: unexpected shapes (n_in %d, in0 %d, out %d, ws %zu)\n", n_in, n_in > 0 ? in_sizes[0] : -1, out_size, ws_size); grid = -1; return; }
        int dev = 0, cus = 0, per_cu = 0;
        if (hipGetDevice(&dev) != hipSuccess || hipDeviceGetAttribute(&cus, hipDeviceAttributeMultiprocessorCount, dev) != hipSuccess) { grid = -1; return; }
        if (hipFuncSetAttribute((const void*)mk_fwd, hipFuncAttributeMaxDynamicSharedMemorySize, LDS_BYTES) != hipSuccess) { fprintf(stderr, "kernel_launch: hipFuncSetAttribute failed\n"); grid = -1; return; }
        if (hipOccupancyMaxActiveBlocksPerMultiprocessor(&per_cu, (const void*)mk_fwd, NWAVES * 64, LDS_BYTES) != hipSuccess || per_cu < 1) { fprintf(stderr, "kernel_launch: occupancy query says %d blocks per CU\n", per_cu); (void)hipGetLastError(); grid = -1; return; }
        grid = cus;
        if (grid != 256) fprintf(stderr, "kernel_launch: %d CUs; this kernel is laid out for 256\n", grid);
    }
    if (grid < 0) return;
    (void)hipMemsetAsync((char*)d_ws + WS_CTL, 0, CTL_ZERO_BYTES, stream);
    Args a{};
    for (int i = 0; i < 13; ++i) a.in[i] = (const float*)d_in[i];
    a.out = (float*)d_out; a.ws = (unsigned char*)d_ws;
#if MK_PER_PHASE
    for (int ph = 0; ph < NPHASE; ++ph) { a.ph_lo = ph; a.ph_hi = ph + 1; hipLaunchKernelGGL(mk_fwd, dim3(grid), dim3(NWAVES * 64), LDS_BYTES, stream, a); }
#else
    a.ph_lo = 0; a.ph_hi = NPHASE;
    hipLaunchKernelGGL(mk_fwd, dim3(grid), dim3(NWAVES * 64), LDS_BYTES, stream, a);
#endif
}
```
